# Optimizing an MI355X kernel written in HIP

```python
import jax
import jax.numpy as jnp
from jax import lax
import numpy as np

D_MODEL = 1024
BATCH = 8
SEQ = 2048
DEPTH = 2

N_A_LAYERS = DEPTH // 2
N_B_LAYERS = DEPTH - N_A_LAYERS

A_HEAD_DIM = 128
A_HEADS = D_MODEL // A_HEAD_DIM
A_WIDTH = A_HEADS * A_HEAD_DIM
A_CONV = 4
A_CHUNK = 64
A_PROJ = 4 * A_WIDTH + 2 * A_HEADS

B_HEAD_DIM = 64
B_Q_HEADS = D_MODEL // B_HEAD_DIM
B_KV_HEADS = max(1, B_Q_HEADS // 8)
B_GROUP = B_Q_HEADS // B_KV_HEADS
WINDOW = 128
ROPE_DIM = B_HEAD_DIM // 4
ROPE_THETA = 500000.0

N_EXPERTS = 32
TOP_K = 4
D_FF = D_MODEL
SWIGLU_LIMIT = 7.0
SWIGLU_ALPHA = 1.702
MOE_BLOCK = 128

EPS = 1e-6
F32 = jnp.float32

kernel_name = "yoco_gdn_swa_sink_moe_adaln"


def rms_norm(x, gain):
    xf = x.astype(F32)
    y = xf * lax.rsqrt(jnp.mean(xf * xf, axis=-1, keepdims=True) + EPS)
    return (y * gain.astype(F32)).astype(x.dtype)


def ada_norm(x, gain, shift, scale):
    return rms_norm(x, gain) * (1.0 + scale[:, None, :]) + shift[:, None, :]


def l2_norm(x):
    xf = x.astype(F32)
    return (xf * lax.rsqrt(jnp.sum(xf * xf, axis=-1, keepdims=True) + EPS)).astype(x.dtype)


def causal_depthwise_conv(x, w):
    k_len = w.shape[0]
    s_len = x.shape[1]
    xp = jnp.pad(x, ((0, 0), (k_len - 1, 0), (0, 0)))
    return sum(xp[:, i:i + s_len] * w[i] for i in range(k_len))


def partial_rope(x, positions):
    inv_freq = ROPE_THETA ** (-jnp.arange(0, ROPE_DIM, 2, dtype=F32) / ROPE_DIM)
    ang = positions.astype(F32)[..., None] * inv_freq
    cos = jnp.cos(ang)[:, :, None, :]
    sin = jnp.sin(ang)[:, :, None, :]
    x1, x2 = jnp.split(x[..., :ROPE_DIM].astype(F32), 2, axis=-1)
    rot = jnp.concatenate([x1 * cos - x2 * sin, x2 * cos + x1 * sin], axis=-1)
    return jnp.concatenate([rot.astype(x.dtype), x[..., ROPE_DIM:]], axis=-1)


def chunk_gated_delta_rule(q, k, v, g, beta):
    b_sz, s_len, n_h, d_k = q.shape
    d_v = v.shape[-1]
    n_c = s_len // A_CHUNK

    def chunks(t):
        t = t.astype(F32).reshape(b_sz, n_c, A_CHUNK, n_h, *t.shape[3:])
        return jnp.moveaxis(t, (1, 3), (0, 2))

    q, k, v, g, beta = map(chunks, (q, k, v, g, beta))
    gc = jnp.cumsum(g, axis=-1)
    idx = jnp.arange(A_CHUNK)
    incl = idx[:, None] >= idx[None, :]
    strict = idx[:, None] > idx[None, :]
    decay = jnp.exp(jnp.where(incl, gc[..., :, None] - gc[..., None, :], -jnp.inf))
    kb = k * beta[..., None]
    a_mat = jnp.where(strict, jnp.einsum('nbhid,nbhjd->nbhij', kb, k) * decay, 0.0)
    rhs = jnp.concatenate([v * beta[..., None], kb * jnp.exp(gc)[..., None]], axis=-1)
    sol = lax.linalg.triangular_solve(a_mat, rhs, left_side=True, lower=True, unit_diagonal=True)
    u, w = sol[..., :d_v], sol[..., d_v:]
    qk = jnp.einsum('nbhid,nbhjd->nbhij', q, k) * decay
    q_dec = q * jnp.exp(gc)[..., None]
    k_tail = k * jnp.exp(gc[..., -1:] - gc)[..., None]
    g_tot = jnp.exp(gc[..., -1])

    def step(state, xs):
        q_c, kt_c, u_c, w_c, qk_c, gt_c = xs
        v_new = u_c - jnp.einsum('bhcd,bhde->bhce', w_c, state)
        o_c = jnp.einsum('bhcd,bhde->bhce', q_c, state) + jnp.einsum('bhij,bhje->bhie', qk_c, v_new)
        state = state * gt_c[..., None, None] + jnp.einsum('bhcd,bhce->bhde', kt_c, v_new)
        return state, o_c

    s0 = jnp.zeros((b_sz, n_h, d_k, d_v), F32)
    _, o = lax.scan(step, s0, (q_dec, k_tail, u, w, qk, g_tot))
    return jnp.moveaxis(o, (0, 2), (1, 3)).reshape(b_sz, s_len, n_h, d_v)


def gated_deltanet(h, w_in, conv_w, a_log, dt_bias, out_gain, w_out):
    b_sz, s_len, _ = h.shape
    proj = h @ w_in
    qkv, z, a, b = jnp.split(proj, [3 * A_WIDTH, 4 * A_WIDTH, 4 * A_WIDTH + A_HEADS], axis=-1)
    qkv = jax.nn.silu(causal_depthwise_conv(qkv, conv_w))
    q, k, v = [t.reshape(b_sz, s_len, A_HEADS, A_HEAD_DIM) for t in jnp.split(qkv, 3, axis=-1)]
    q = l2_norm(q) * (A_HEAD_DIM ** -0.5)
    k = l2_norm(k)
    beta = jax.nn.sigmoid(b.astype(F32))
    g = -jnp.exp(a_log.astype(F32)) * jax.nn.softplus(a.astype(F32) + dt_bias.astype(F32))
    o = chunk_gated_delta_rule(q, k, v, g, beta).astype(h.dtype)
    o = rms_norm(o, out_gain) * jax.nn.silu(z.reshape(b_sz, s_len, A_HEADS, A_HEAD_DIM))
    return o.reshape(b_sz, s_len, A_WIDTH) @ w_out


def shared_kv(x, gain, shift, scale, w_kv, k_gain, positions):
    b_sz, s_len, _ = x.shape
    h = ada_norm(x, gain, shift, scale)
    k, v = jnp.split(h @ w_kv, 2, axis=-1)
    k = k.reshape(b_sz, s_len, B_KV_HEADS, B_HEAD_DIM)
    v = v.reshape(b_sz, s_len, B_KV_HEADS, B_HEAD_DIM)
    k = partial_rope(rms_norm(k, k_gain), positions)
    return k, v


def swa_sink_attention(h, k, v, w_q, q_gain, sinks, w_out, positions):
    b_sz, s_len, _ = h.shape
    n_b = s_len // WINDOW
    q = (h @ w_q).reshape(b_sz, s_len, B_Q_HEADS, B_HEAD_DIM)
    q = partial_rope(rms_norm(q, q_gain), positions)
    qb = q.reshape(b_sz, n_b, WINDOW, B_KV_HEADS, B_GROUP, B_HEAD_DIM)
    kb = k.reshape(b_sz, n_b, WINDOW, B_KV_HEADS, B_HEAD_DIM)
    vb = v.reshape(b_sz, n_b, WINDOW, B_KV_HEADS, B_HEAD_DIM)

    def with_prev(t):
        prev = jnp.concatenate([jnp.zeros_like(t[:, :1]), t[:, :-1]], axis=1)
        return jnp.concatenate([prev, t], axis=2)

    k_band, v_band = with_prev(kb), with_prev(vb)
    s = jnp.einsum('bnqhgd,bnkhd->bnhgqk', qb, k_band, preferred_element_type=F32) * (B_HEAD_DIM ** -0.5)
    qi = jnp.arange(WINDOW)[:, None] + WINDOW
    kj = jnp.arange(2 * WINDOW)[None, :]
    band = (kj <= qi) & (qi - kj < WINDOW)
    has_prev = (jnp.arange(n_b) > 0)[:, None, None] | (kj >= WINDOW)[None]
    mask = band[None] & has_prev
    s = jnp.where(mask[None, :, None, None], s, -jnp.inf)
    sink = sinks.astype(F32).reshape(B_KV_HEADS, B_GROUP)[None, None, :, :, None, None]
    m = jnp.maximum(jnp.max(s, axis=-1, keepdims=True), sink)
    p = jnp.exp(s - m)
    p = p / (jnp.sum(p, axis=-1, keepdims=True) + jnp.exp(sink - m))
    o = jnp.einsum('bnhgqk,bnkhd->bnqhgd', p.astype(v.dtype), v_band)
    return o.reshape(b_sz, s_len, B_Q_HEADS * B_HEAD_DIM) @ w_out


def moe_ffn(h, router_w, router_b, up_w, up_b, down_w, down_b):
    b_sz, s_len, d = h.shape
    n_tok = b_sz * s_len
    xt = h.reshape(n_tok, d)
    logits = jnp.dot(xt, router_w, preferred_element_type=F32) + router_b.astype(F32)
    top_logit, top_idx = lax.top_k(logits, TOP_K)
    gates = jax.nn.softmax(top_logit, axis=-1)
    n_as = n_tok * TOP_K
    flat_e = top_idx.reshape(-1).astype(jnp.int32)
    order = jnp.argsort(flat_e)
    sorted_e = flat_e[order]
    counts = jnp.bincount(flat_e, length=N_EXPERTS).astype(jnp.int32)
    starts = jnp.cumsum(counts) - counts
    padded = (counts + MOE_BLOCK - 1) // MOE_BLOCK * MOE_BLOCK
    p_ends = jnp.cumsum(padded)
    p_starts = p_ends - padded
    rank = jnp.arange(n_as, dtype=jnp.int32) - starts[sorted_e]
    dest_sorted = p_starts[sorted_e] + rank
    n_rows = n_as + N_EXPERTS * MOE_BLOCK
    n_blk = n_rows // MOE_BLOCK
    row_token = jnp.full((n_rows,), n_tok, jnp.int32).at[dest_sorted].set((order // TOP_K).astype(jnp.int32))
    x_pad = jnp.concatenate([xt, jnp.zeros((1, d), xt.dtype)], axis=0)
    xb = x_pad[row_token].reshape(n_blk, MOE_BLOCK, d)
    blk_start = jnp.arange(n_blk, dtype=jnp.int32) * MOE_BLOCK
    blk_expert = jnp.clip(jnp.searchsorted(p_ends, blk_start, side='right'), 0, N_EXPERTS - 1)

    def expert_block(args):
        xblk, e = args
        gu = xblk @ up_w[e] + up_b[e]
        gate, lin = jnp.split(gu, 2, axis=-1)
        gate = jnp.minimum(gate, SWIGLU_LIMIT)
        lin = jnp.clip(lin, -SWIGLU_LIMIT, SWIGLU_LIMIT)
        act = gate * jax.nn.sigmoid(SWIGLU_ALPHA * gate) * (lin + 1.0)
        return act @ down_w[e] + down_b[e]

    y_rows = lax.map(expert_block, (xb, blk_expert)).reshape(n_rows, d)
    dest = jnp.zeros((n_as,), jnp.int32).at[order].set(dest_sorted)
    y = jnp.einsum('tkd,tk->td', y_rows[dest].reshape(n_tok, TOP_K, d), gates.astype(h.dtype))
    return y.reshape(b_sz, s_len, d)


def _normal(k, shape, scale):
    return jax.random.normal(k, shape, F32) * scale


def setup_inputs(seed: int = 0) -> dict:
    key = jax.random.key(seed)
    ks = jax.random.split(key, 32)
    d = D_MODEL
    x = _normal(ks[0], (BATCH, SEQ, d), 1.0)
    c = _normal(ks[1], (BATCH, d), 1.0)
    offset = jax.random.randint(ks[2], (BATCH, 1), 0, 4096, dtype=jnp.int32)
    positions = offset + jnp.arange(SEQ, dtype=jnp.int32)[None, :]

    ada_w = _normal(ks[3], (DEPTH, d, 6 * d), 0.5 * d ** -0.5)
    ada_b = _normal(ks[4], (DEPTH, 6 * d), 0.02)
    norm_gain = 1.0 + _normal(ks[5], (DEPTH, 2, d), 0.02)

    a_w_in = _normal(ks[6], (N_A_LAYERS, d, A_PROJ), d ** -0.5)
    a_conv = _normal(ks[7], (N_A_LAYERS, A_CONV, 3 * A_WIDTH), A_CONV ** -0.5)
    a_log = jnp.log(jax.random.uniform(ks[8], (N_A_LAYERS, A_HEADS), F32, 1.0, 16.0))
    dt = jnp.exp(jax.random.uniform(ks[9], (N_A_LAYERS, A_HEADS), F32, np.log(1e-3), np.log(1e-1)))
    a_dt_bias = dt + jnp.log(-jnp.expm1(-dt))
    a_out_gain = 1.0 + _normal(ks[10], (N_A_LAYERS, A_HEAD_DIM), 0.02)
    a_w_out = _normal(ks[11], (N_A_LAYERS, A_WIDTH, d), A_WIDTH ** -0.5)

    kv_ada_w = _normal(ks[12], (d, 2 * d), 0.5 * d ** -0.5)
    kv_ada_b = _normal(ks[13], (2 * d,), 0.02)
    kv_norm_gain = 1.0 + _normal(ks[14], (d,), 0.02)
    kv_w = _normal(ks[15], (d, 2 * B_KV_HEADS * B_HEAD_DIM), d ** -0.5)
    k_norm_gain = 1.0 + _normal(ks[16], (B_HEAD_DIM,), 0.02)

    b_w_q = _normal(ks[17], (N_B_LAYERS, d, B_Q_HEADS * B_HEAD_DIM), d ** -0.5)
    q_norm_gain = 1.0 + _normal(ks[18], (N_B_LAYERS, B_HEAD_DIM), 0.02)
    b_sinks = _normal(ks[19], (N_B_LAYERS, B_Q_HEADS), 0.5)
    b_w_out = _normal(ks[20], (N_B_LAYERS, B_Q_HEADS * B_HEAD_DIM, d), (B_Q_HEADS * B_HEAD_DIM) ** -0.5)

    router_w = _normal(ks[21], (DEPTH, d, N_EXPERTS), d ** -0.5)
    router_b = _normal(ks[22], (DEPTH, N_EXPERTS), 0.01)
    up_w = _normal(ks[23], (DEPTH, N_EXPERTS, d, 2 * D_FF), d ** -0.5)
    up_b = _normal(ks[24], (DEPTH, N_EXPERTS, 2 * D_FF), 0.01)
    down_w = _normal(ks[25], (DEPTH, N_EXPERTS, D_FF, d), D_FF ** -0.5)
    down_b = _normal(ks[26], (DEPTH, N_EXPERTS, d), 0.01)
    return {
        "x": x, "c": c, "positions": positions,
        "ada_w": ada_w, "ada_b": ada_b, "norm_gain": norm_gain,
        "a_w_in": a_w_in, "a_conv": a_conv, "a_log": a_log, "a_dt_bias": a_dt_bias,
        "a_out_gain": a_out_gain, "a_w_out": a_w_out,
        "kv_ada_w": kv_ada_w, "kv_ada_b": kv_ada_b, "kv_norm_gain": kv_norm_gain,
        "kv_w": kv_w, "k_norm_gain": k_norm_gain,
        "b_w_q": b_w_q, "q_norm_gain": q_norm_gain, "b_sinks": b_sinks, "b_w_out": b_w_out,
        "router_w": router_w, "router_b": router_b, "up_w": up_w, "up_b": up_b,
        "down_w": down_w, "down_b": down_b,
    }


def reference(x, c, positions, ada_w, ada_b, norm_gain, a_w_in, a_conv, a_log, a_dt_bias,
              a_out_gain, a_w_out, kv_ada_w, kv_ada_b, kv_norm_gain, kv_w, k_norm_gain,
              b_w_q, q_norm_gain, b_sinks, b_w_out, router_w, router_b, up_w, up_b,
              down_w, down_b):
    c_act = jax.nn.silu(c)
    k_sh, v_sh = None, None
    for layer in range(DEPTH):
        if layer == N_A_LAYERS:
            kv_shift, kv_scale = jnp.split(c_act @ kv_ada_w + kv_ada_b, 2, axis=-1)
            k_sh, v_sh = shared_kv(x, kv_norm_gain, kv_shift, kv_scale, kv_w, k_norm_gain, positions)
        mod = c_act @ ada_w[layer] + ada_b[layer]
        sh1, sc1, g1, sh2, sc2, g2 = jnp.split(mod, 6, axis=-1)
        h = ada_norm(x, norm_gain[layer, 0], sh1, sc1)
        if layer < N_A_LAYERS:
            y = gated_deltanet(h, a_w_in[layer], a_conv[layer], a_log[layer], a_dt_bias[layer],
                               a_out_gain[layer], a_w_out[layer])
        else:
            j = layer - N_A_LAYERS
            y = swa_sink_attention(h, k_sh, v_sh, b_w_q[j], q_norm_gain[j], b_sinks[j],
                                   b_w_out[j], positions)
        x = x + g1[:, None, :] * y
        h = ada_norm(x, norm_gain[layer, 1], sh2, sc2)
        y = moe_ffn(h, router_w[layer], router_b[layer], up_w[layer], up_b[layer],
                    down_w[layer], down_b[layer])
        x = x + g2[:, None, :] * y
    return x
```

```cpp
#include <hip/hip_runtime.h>
#include <cstdio>
#include <cstdint>

#define GAS __attribute__((address_space(1)))
#define LAS __attribute__((address_space(3)))
#define DI __device__ __forceinline__
typedef unsigned short bf16;
typedef short bf16x8 __attribute__((ext_vector_type(8)));
typedef short bf16x4 __attribute__((ext_vector_type(4)));
typedef float f32x4 __attribute__((ext_vector_type(4)));
typedef float f32x2 __attribute__((ext_vector_type(2)));
typedef unsigned u32x4 __attribute__((ext_vector_type(4)));
typedef unsigned u32x2 __attribute__((ext_vector_type(2)));

constexpr int NB = 8, SEQ = 2048, D = 1024, T = NB * SEQ;
constexpr int AH = 8, NCH = SEQ / 64;
constexpr int NE = 32, LISTCAP = 16384;
constexpr int MODW = 14336;
constexpr int NWAVES = 8, NTHR = 512;
constexpr float EPS = 1e-6f;

constexpr size_t MiB = 1u << 20;
constexpr size_t WS_CTL = 0, CTL_ZERO_BYTES = 1 * MiB;
constexpr size_t WS_MOD = 1 * MiB, WS_ROPE = 2 * MiB, WS_AB = 3 * MiB, WS_RGATE = 4 * MiB, WS_LIST = 5 * MiB, WS_GTOT = 7 * MiB;
constexpr size_t WS_WIN_T = 8 * MiB, WS_WOUT_T = 16 * MiB, WS_KV_T = 18 * MiB, WS_WQ_T = 19 * MiB, WS_BWOUT_T = 21 * MiB;
constexpr size_t WS_UP_T = 32 * MiB, WS_DOWN_T = 288 * MiB;
constexpr size_t WS_H = 416 * MiB, WS_HQ = 448 * MiB, WS_HKV = 480 * MiB, WS_PROJ = 512 * MiB;
constexpr size_t WS_UT = 640 * MiB, WS_WNEG = 704 * MiB, WS_QD = 736 * MiB, WS_KTT = 768 * MiB, WS_QK = 800 * MiB;
constexpr size_t WS_O = 816 * MiB, WS_ON = 848 * MiB, WS_X1 = 880 * MiB, WS_X2 = 944 * MiB;
constexpr size_t WS_ACT = 1008 * MiB, WS_YS = 1152 * MiB, WS_QKV = 1280 * MiB, WS_QN = 1320 * MiB, WS_KN = 1352 * MiB, WS_VT = 1356 * MiB;
constexpr size_t WS_END = 1360 * MiB;
constexpr int CW_CNT = 1024;
constexpr int CW_BAR = 4096;

constexpr int RING_BYTES = 131072;
constexpr int LDS_BYTES = 147456;
constexpr int MISC_OFF = LDS_BYTES - 2048;
constexpr int TAB_OFF = MISC_OFF + 256;

DI unsigned f2bf(float f) { unsigned u = __builtin_bit_cast(unsigned, f); return (u + 0x7fffu + ((u >> 16) & 1u)) >> 16; }
DI unsigned pk2(float lo, float hi) { return f2bf(lo) | (f2bf(hi) << 16); }
DI float bf2f(unsigned b) { return __builtin_bit_cast(float, b << 16); }
DI float bflo(unsigned w) { return __builtin_bit_cast(float, w << 16); }
DI float bfhi(unsigned w) { return __builtin_bit_cast(float, w & 0xffff0000u); }
DI float wave_sum(float v) {
#pragma unroll
    for (int o = 1; o < 64; o <<= 1) v += __shfl_xor(v, o);
    return v;
}
DI float sigmoidf_(float x) { return 1.f / (1.f + __expf(-x)); }
DI float siluf_(float x) { return x / (1.f + __expf(-x)); }
#define LDS_WAIT() asm volatile("s_waitcnt lgkmcnt(0)" ::: "memory")
#define VM_WAIT() asm volatile("s_waitcnt vmcnt(0)" ::: "memory")
#define MFMA16(a, b, c) __builtin_amdgcn_mfma_f32_16x16x32_bf16((a), (b), (c), 0, 0, 0)

#define XB_TMO      128
#define XB_XCNT(j)  (256  + 64 * (j))
#define XB_XSUB(j)  (1280 + 64 * (j))
#define XB_XGEN(j)  (2304 + 64 * (j))
#define XB_TOP      3328
#define XB_TOPGEN   3392
#define XCD_BAR_WORDS 3456
#define XB_SPIN_CAP (1u << 18)
__device__ __forceinline__ unsigned xb_ld(unsigned* p)              { return __hip_atomic_load(p, __ATOMIC_RELAXED, __HIP_MEMORY_SCOPE_AGENT); }
__device__ __forceinline__ unsigned xb_add(unsigned* p, unsigned v) { return __hip_atomic_fetch_add(p, v, __ATOMIC_RELAXED, __HIP_MEMORY_SCOPE_AGENT); }
__device__ __forceinline__ unsigned xb_xcc_id() { return (unsigned)__builtin_amdgcn_s_getreg((3 << 11) | 20) & 0xFu; }
#define XB_SPIN(cond, bar) do { unsigned _sp = 0; while (cond) { __builtin_amdgcn_s_sleep(1); \
    if ((++_sp & 255u) == 0u) { if (xb_ld(&(bar)[XB_TMO])) break; if (_sp > XB_SPIN_CAP) { atomicAdd(&(bar)[XB_TMO], 1u); break; } } } } while (0)
struct XcdBarrier { unsigned* bar; unsigned x; volatile LAS unsigned* st; };
__device__ __forceinline__ XcdBarrier xcd_barrier_post(unsigned* bar, volatile LAS unsigned* st) {
    XcdBarrier b; b.bar = bar; b.x = xb_xcc_id(); b.st = st;
    if (threadIdx.x == 0) (void)xb_add(&bar[XB_XCNT(b.x)], 1u);
    return b;
}
__device__ __forceinline__ void xcd_barrier_complete(unsigned* bar, unsigned x, unsigned& nloc, unsigned& nx) {
    const unsigned G = gridDim.x * gridDim.y * gridDim.z;
    unsigned sum, cnt, mine, sp = 0u;
    for (;;) {
        sum = 0u; cnt = 0u; mine = 0u;
#pragma unroll
        for (unsigned j = 0; j < 16; ++j) { const unsigned c = xb_ld(&bar[XB_XCNT(j)]); sum += c; cnt += (c > 0u) ? 1u : 0u; mine = (j == x) ? c : mine; }
        if (sum == G) break;
        __builtin_amdgcn_s_sleep(1);
        if ((++sp & 255u) == 0u) { if (xb_ld(&bar[XB_TMO])) break; if (sp > XB_SPIN_CAP) { atomicAdd(&bar[XB_TMO], 1u); break; } }
    }
    nloc = mine > 0u ? mine : 1u; nx = cnt > 0u ? cnt : 1u;
}
__device__ __forceinline__ void xcd_barrier(const XcdBarrier& b) {
    asm volatile("s_waitcnt vmcnt(0)" ::: "memory");
    __syncthreads();
    if (threadIdx.x == 0) {
        unsigned* bar = b.bar;
        __builtin_amdgcn_s_waitcnt(0);
        unsigned nloc = b.st[0], nx = b.st[1];
        if (nloc == 0u) { xcd_barrier_complete(bar, b.x, nloc, nx); b.st[0] = nloc; b.st[1] = nx; }
        const unsigned old = xb_add(&bar[XB_XSUB(b.x)], 1u);
        const unsigned gen = old / nloc;
        if (old + 1u == (gen + 1u) * nloc) {
            __builtin_amdgcn_fence(__ATOMIC_RELEASE, "agent");
            asm volatile("s_waitcnt vmcnt(0)" ::: "memory");
            const unsigned og = xb_add(&bar[XB_TOP], 1u);
            const unsigned tg = og / nx;
            if (og + 1u == (tg + 1u) * nx) xb_add(&bar[XB_TOPGEN], 1u);
            else XB_SPIN(xb_ld(&bar[XB_TOPGEN]) == tg, bar);
            __builtin_amdgcn_fence(__ATOMIC_ACQUIRE, "agent");
            xb_add(&bar[XB_XGEN(b.x)], 1u);
            asm volatile("s_waitcnt vmcnt(0)" ::: "memory");
        } else {
            XB_SPIN(xb_ld(&bar[XB_XGEN(b.x)]) == gen, bar);
            __builtin_amdgcn_fence(__ATOMIC_ACQUIRE, "agent");
            asm volatile("s_waitcnt vmcnt(0)" ::: "memory");
        }
    }
    __syncthreads();
}

namespace pg8 {
constexpr int BM = 256, BK = 64, HALF = 128, HTB = HALF * BK * 2, KD = 1024;
__host__ __device__ __forceinline__ int lds_byte(int r, int c) { const int st = (r >> 4) * 2 + (c >> 5), rr = r & 15, cc = c & 31, ob = rr * 64 + cc * 2; return st * 1024 + (ob ^ (((ob >> 9) & 1) << 5)); }
__host__ __device__ __forceinline__ void stage_rc(int b, int& R, int& C) { const int st = b / 1024, sb = b % 1024, swz = sb ^ (((sb >> 9) & 1) << 5); R = (st >> 1) * 16 + swz / 64; C = (st & 1) * 32 + (swz % 64) / 2; }
__host__ __device__ __forceinline__ int perm32(int rho) { const int n = rho >> 4, i = rho & 15; return 8 * (i >> 2) + 4 * n + (i & 3); }
struct Unit { int pm, pn, e, rows, mt; };
__device__ __forceinline__ unsigned cvt_pk_bf16(float lo, float hi) { unsigned r; asm volatile("v_cvt_pk_bf16_f32 %0, %1, %2" : "=v"(r) : "v"(lo), "v"(hi)); return r; }

template <class Epi, class Sched>
__device__ __forceinline__ void gemm_phase(LAS unsigned char* lds, const Sched& S, const Epi& E) {
    const int tid = threadIdx.x, wid = __builtin_amdgcn_readfirstlane(tid >> 6), lane = tid & 63, wr = wid >> 2, wc = wid & 3, fr = lane & 15, fq = lane >> 4;
    constexpr int K = KD, nt = K / BK;
    int Rr[2], Cc[2]; unsigned voffB[2];
#pragma unroll
    for (int i = 0; i < 2; ++i) { stage_rc(tid * 16 + i * 8192, Rr[i], Cc[i]); const int Rb = Epi::PERM ? ((Rr[i] & ~31) + perm32(Rr[i] & 31)) : Rr[i]; voffB[i] = (unsigned)(Rb * K + Cc[i]) * 2u; }
    const size_t kstep = (size_t)(BK * 2);
    const size_t hstep = (size_t)HALF * K * 2;
    const unsigned ldsw = (unsigned)wid * 1024u;
    const int aoff = lds_byte(wr * 64 + fr, fq * 8), boff = lds_byte(wc * 32 + fr, fq * 8);
#define PG8_SA(b, h) (((b) * 2 + (h)) * HTB)
#define PG8_SB(b, h) ((4 + (b) * 2 + (h)) * HTB)
#define PG8_STAGE(bufoff, gbase, voff) do { _Pragma("unroll") for (int _i = 0; _i < 2; ++_i) \
        __builtin_amdgcn_global_load_lds((const unsigned*)((const char*)(gbase) + (voff)[_i]), (LAS unsigned*)(lds + (bufoff) + ldsw + _i * 8192), 16, 0, 0); } while (0)
#define PG8_LDA(dst, b, h) do { _Pragma("unroll") for (int m = 0; m < 4; ++m) _Pragma("unroll") for (int k = 0; k < 2; ++k) dst[m][k] = *(const LAS bf16x8*)(lds + PG8_SA(b, h) + aoff + m * 2048 + k * 1024); } while (0)
#define PG8_LDB(dst, b, h) do { _Pragma("unroll") for (int n = 0; n < 2; ++n) _Pragma("unroll") for (int k = 0; k < 2; ++k) dst[n][k] = *(const LAS bf16x8*)(lds + PG8_SB(b, h) + boff + n * 2048 + k * 1024); } while (0)
#define PG8_MMA(ai, bj, At, Bt) do { __builtin_amdgcn_s_setprio(1); _Pragma("unroll") for (int m = 0; m < 4; ++m) _Pragma("unroll") for (int n = 0; n < 2; ++n) _Pragma("unroll") for (int k = 0; k < 2; ++k) \
        acc[ai][bj][m][n] = __builtin_amdgcn_mfma_f32_16x16x32_bf16(Bt[n][k], At[m][k], acc[ai][bj][m][n], 0, 0, 0); __builtin_amdgcn_s_setprio(0); } while (0)
#define PG8_WAIT_V(n) asm volatile("s_waitcnt vmcnt(" #n ")" ::: "memory")
#define PG8_WAIT_L(n) asm volatile("s_waitcnt lgkmcnt(" #n ")" ::: "memory")
#define PG8_BAR __builtin_amdgcn_s_barrier()
#define PG8_SCHED __builtin_amdgcn_sched_barrier(0)
    Unit cur, nxt; int ui = 0;
    if (!S.next(0, cur)) return;
    f32x4 acc[2][2][4][2];
#pragma unroll
    for (int a = 0; a < 2; ++a)
#pragma unroll
        for (int b = 0; b < 2; ++b)
#pragma unroll
            for (int m = 0; m < 4; ++m)
#pragma unroll
                for (int n = 0; n < 2; ++n) acc[a][b][m][n] = (f32x4){0.f, 0.f, 0.f, 0.f};
    bf16x8 At[4][2], B0[2][2], B1[2][2];
    unsigned va[2][2], nva[2][2];
#pragma unroll
    for (int h = 0; h < 2; ++h)
#pragma unroll
        for (int i = 0; i < 2; ++i) va[h][i] = S.a_off(cur, h * HALF + Rr[i], Cc[i]);
    const char* cA = S.a_base(cur); const char* cB = S.b_base(cur);
    PG8_STAGE(PG8_SB(0, 0), cB, voffB); PG8_STAGE(PG8_SA(0, 0), cA, va[0]); PG8_STAGE(PG8_SB(0, 1), cB + hstep, voffB); PG8_STAGE(PG8_SA(0, 1), cA, va[1]);
    if (wr == 1) PG8_BAR;
    PG8_WAIT_V(4); PG8_BAR;
    PG8_STAGE(PG8_SB(1, 0), cB + kstep, voffB); PG8_STAGE(PG8_SA(1, 0), cA + kstep, va[0]); PG8_STAGE(PG8_SB(1, 1), cB + hstep + kstep, voffB);
    PG8_WAIT_V(6); PG8_BAR;
    for (;;) {
        const bool has_next = S.next(ui + 1, nxt);
        const char* nA = cA; const char* nB = cB;
#pragma unroll
        for (int h = 0; h < 2; ++h)
#pragma unroll
            for (int i = 0; i < 2; ++i) nva[h][i] = va[h][i];
        if (has_next) {
            nA = S.a_base(nxt); nB = S.b_base(nxt);
#pragma unroll
            for (int h = 0; h < 2; ++h)
#pragma unroll
                for (int i = 0; i < 2; ++i) nva[h][i] = S.a_off(nxt, h * HALF + Rr[i], Cc[i]);
        }
        asm volatile("" : "+v"(nva[0][0]), "+v"(nva[0][1]), "+v"(nva[1][0]), "+v"(nva[1][1]));
        for (int t = 0; t < nt; t += 2) {
            const bool last = (t == nt - 2);
            const char* a1 = cA + (size_t)(t + 1) * kstep;
            const char* a2 = last ? nA : cA + (size_t)(t + 2) * kstep; const char* b2 = last ? nB : cB + (size_t)(t + 2) * kstep;
            const char* a3 = a2 + kstep; const char* b3 = b2 + kstep;
            unsigned v2[2][2];
#pragma unroll
            for (int h = 0; h < 2; ++h)
#pragma unroll
                for (int i = 0; i < 2; ++i) v2[h][i] = last ? nva[h][i] : va[h][i];
            PG8_LDB(B0, 0, 0); PG8_SCHED; PG8_LDA(At, 0, 0); PG8_STAGE(PG8_SA(1, 1), a1, va[1]);
            PG8_WAIT_L(8); PG8_BAR; PG8_WAIT_L(0); PG8_MMA(0, 0, At, B0); PG8_BAR; PG8_SCHED;
            PG8_LDB(B1, 0, 1); PG8_STAGE(PG8_SB(0, 0), b2, voffB);
            PG8_BAR; PG8_WAIT_L(0); PG8_MMA(0, 1, At, B1); PG8_BAR;
            PG8_LDA(At, 0, 1); PG8_STAGE(PG8_SA(0, 0), a2, v2[0]);
            PG8_BAR; PG8_WAIT_L(0); PG8_MMA(1, 0, At, B0); PG8_BAR; PG8_SCHED;
            PG8_STAGE(PG8_SB(0, 1), b2 + hstep, voffB);
            PG8_WAIT_V(6); PG8_BAR; PG8_MMA(1, 1, At, B1); PG8_BAR;
            PG8_LDB(B0, 1, 0); PG8_SCHED; PG8_LDA(At, 1, 0); PG8_STAGE(PG8_SA(0, 1), a2, v2[1]);
            PG8_WAIT_L(8); PG8_BAR; PG8_WAIT_L(0); PG8_MMA(0, 0, At, B0); PG8_BAR; PG8_SCHED;
            PG8_LDB(B1, 1, 1); PG8_STAGE(PG8_SB(1, 0), b3, voffB);
            PG8_BAR; PG8_WAIT_L(0); PG8_MMA(0, 1, At, B1); PG8_BAR;
            PG8_LDA(At, 1, 1); PG8_STAGE(PG8_SA(1, 0), a3, v2[0]);
            PG8_BAR; PG8_WAIT_L(0); PG8_MMA(1, 0, At, B0); PG8_BAR; PG8_SCHED;
            PG8_STAGE(PG8_SB(1, 1), b3 + hstep, voffB);
            PG8_WAIT_V(6); PG8_BAR; PG8_MMA(1, 1, At, B1); PG8_BAR;
        }
        E(acc, cur, wr, wc, fr, fq);
        if (!has_next) break;
#pragma unroll
        for (int a = 0; a < 2; ++a)
#pragma unroll
            for (int b = 0; b < 2; ++b)
#pragma unroll
                for (int m = 0; m < 4; ++m)
#pragma unroll
                    for (int n = 0; n < 2; ++n) acc[a][b][m][n] = (f32x4){0.f, 0.f, 0.f, 0.f};
        cur = nxt; cA = nA; cB = nB; ++ui;
#pragma unroll
        for (int h = 0; h < 2; ++h)
#pragma unroll
            for (int i = 0; i < 2; ++i) va[h][i] = nva[h][i];
    }
    PG8_WAIT_V(0);
    if (wr == 0) PG8_BAR;
    PG8_BAR;
#undef PG8_SA
#undef PG8_SB
#undef PG8_STAGE
#undef PG8_LDA
#undef PG8_LDB
#undef PG8_MMA
#undef PG8_WAIT_V
#undef PG8_WAIT_L
#undef PG8_BAR
#undef PG8_SCHED
}

struct PlainSched {
    const bf16* A; const bf16* Bt; int nM, nN, G, c;
    __device__ __forceinline__ bool next(int i, Unit& u) const {
        const int nwg = nM * nN; const long L = (long)i * G + c; if (L >= nwg) return false;
        int wgid = (int)L; { const int q = nwg / 8, r = nwg % 8, xcd = wgid % 8, off = wgid / 8; wgid = (xcd < r ? xcd * (q + 1) : r * (q + 1) + (xcd - r) * q) + off; }
        const int nig = 8 * nN, gid = wgid / nig, fm = gid * 8, gsz = (nM - fm) < 8 ? (nM - fm) : 8;
        u.pm = fm + ((wgid % nig) % gsz); u.pn = (wgid % nig) / gsz; u.e = 0; u.rows = 256; u.mt = 0; return true;
    }
    __device__ __forceinline__ const char* a_base(const Unit& u) const { return (const char*)A + (size_t)u.pm * (256 * KD * 2); }
    __device__ __forceinline__ const char* b_base(const Unit& u) const { return (const char*)Bt + (size_t)u.pn * (256 * KD * 2); }
    __device__ __forceinline__ unsigned a_off(const Unit&, int row, int col) const { return (unsigned)(row * KD + col) * 2u; }
};
struct KvqSched {
    const bf16* Akv; const bf16* Aq; const bf16* Bkv; const bf16* Bq; int G, c;
    __device__ __forceinline__ bool next(int i, Unit& u) const {
        const int L = i * G + c; if (L >= 64 * 5) return false;
        u.pm = L / 5; u.pn = L % 5; u.e = 0; u.rows = 256; u.mt = 0; return true;
    }
    __device__ __forceinline__ const char* a_base(const Unit& u) const { return (const char*)(u.pn == 0 ? Akv : Aq) + (size_t)u.pm * (256 * KD * 2); }
    __device__ __forceinline__ const char* b_base(const Unit& u) const { return u.pn == 0 ? (const char*)Bkv : (const char*)Bq + (size_t)(u.pn - 1) * (256 * KD * 2); }
    __device__ __forceinline__ unsigned a_off(const Unit&, int row, int col) const { return (unsigned)(row * KD + col) * 2u; }
};
template <int NPN, bool GATHER>
struct MoeSched {
    const bf16* A; const bf16* Bt; const int* list; const LAS int* tab; int G, c; size_t bstride;
    __device__ __forceinline__ bool next(int i, Unit& u) const {
        const int ntiles = tab[32 + 32]; const int L = i * G + c; const int tile = L / NPN;
        if (tile >= ntiles) return false;
        const int e = tab[80 + tile]; u.pm = tile; u.pn = L % NPN; u.e = e; u.mt = tile - tab[32 + e];
        const int rem = tab[e] - u.mt * 256; u.rows = rem < 256 ? rem : 256; return true;
    }
    __device__ __forceinline__ const char* a_base(const Unit& u) const { return GATHER ? (const char*)A : (const char*)A + (size_t)u.pm * (256 * KD * 2); }
    __device__ __forceinline__ const char* b_base(const Unit& u) const { return (const char*)(Bt + (size_t)u.e * bstride) + (size_t)u.pn * (256 * KD * 2); }
    __device__ __forceinline__ unsigned a_off(const Unit& u, int row, int col) const {
        if (!GATHER) return (unsigned)(row * KD + col) * 2u;
        const int tok = row < u.rows ? (list[u.e * LISTCAP + u.mt * 256 + row] >> 2) : 0;
        return (unsigned)(tok * KD + col) * 2u;
    }
};

struct EpiBf16 {
    static constexpr bool PERM = true;
    bf16* O; int ldc;
    __device__ __forceinline__ void operator()(const f32x4 (&acc)[2][2][4][2], const Unit& u, int wr, int wc, int fr, int fq) const {
        const int row0 = u.pm * BM + wr * 64 + fr, col0 = u.pn * BM + wc * 32 + 8 * fq;
#pragma unroll
        for (int ai = 0; ai < 2; ++ai)
#pragma unroll
            for (int m = 0; m < 4; ++m) { bf16* rowp = O + (size_t)(row0 + ai * HALF + m * 16) * ldc + col0;
#pragma unroll
                for (int bj = 0; bj < 2; ++bj) { const f32x4 v0 = acc[ai][bj][m][0], v1 = acc[ai][bj][m][1];
                    u32x4 w; w.x = cvt_pk_bf16(v0[0], v0[1]); w.y = cvt_pk_bf16(v0[2], v0[3]); w.z = cvt_pk_bf16(v1[0], v1[1]); w.w = cvt_pk_bf16(v1[2], v1[3]);
                    *(u32x4*)(rowp + bj * HALF) = w; } }
    }
};
struct EpiResid {
    static constexpr bool PERM = false;
    const float* base; float* out; const float* gate;
    __device__ __forceinline__ void operator()(const f32x4 (&acc)[2][2][4][2], const Unit& u, int wr, int wc, int fr, int fq) const {
        const int row0 = u.pm * BM + wr * 64 + fr, col0 = u.pn * BM + wc * 32 + 4 * fq;
        const float* gp = gate + (size_t)(u.pm / 8) * MODW + col0;
        f32x4 gv[2][2];
#pragma unroll
        for (int bj = 0; bj < 2; ++bj)
#pragma unroll
            for (int n = 0; n < 2; ++n) gv[bj][n] = *(const f32x4*)(gp + bj * HALF + n * 16);
#pragma unroll
        for (int ai = 0; ai < 2; ++ai)
#pragma unroll
            for (int m = 0; m < 4; ++m) { const size_t off = (size_t)(row0 + ai * HALF + m * 16) * D + col0;
#pragma unroll
                for (int bj = 0; bj < 2; ++bj)
#pragma unroll
                    for (int n = 0; n < 2; ++n) { const f32x4 bs = *(const f32x4*)(base + off + bj * HALF + n * 16);
                        *(f32x4*)(out + off + bj * HALF + n * 16) = bs + gv[bj][n] * acc[ai][bj][m][n]; }
                asm volatile("" ::: "memory"); }
    }
};
struct EpiSwiglu {
    static constexpr bool PERM = true;
    bf16* act; const float* upb;
    __device__ __forceinline__ void operator()(const f32x4 (&acc)[2][2][4][2], const Unit& u, int wr, int wc, int fr, int fq) const {
        const int row0 = u.pm * BM + wr * 64 + fr, j0 = u.pn * HALF + wc * 32 + 8 * fq;
        const float* bp = upb + (size_t)u.e * 2048 + j0;
        f32x4 bg[2], bl[2];
#pragma unroll
        for (int n = 0; n < 2; ++n) { bg[n] = *(const f32x4*)(bp + 4 * n); bl[n] = *(const f32x4*)(bp + 1024 + 4 * n); }
#pragma unroll
        for (int ai = 0; ai < 2; ++ai)
#pragma unroll
            for (int m = 0; m < 4; ++m) { float o[8];
#pragma unroll
                for (int n = 0; n < 2; ++n) { const f32x4 g = acc[ai][0][m][n] + bg[n], l = acc[ai][1][m][n] + bl[n];
#pragma unroll
                    for (int j = 0; j < 4; ++j) { const float gg = fminf(g[j], 7.0f), ll = fminf(fmaxf(l[j], -7.0f), 7.0f);
                        o[4 * n + j] = gg * (1.f / (1.f + __expf(-1.702f * gg))) * (ll + 1.0f); } }
                u32x4 w; w.x = cvt_pk_bf16(o[0], o[1]); w.y = cvt_pk_bf16(o[2], o[3]); w.z = cvt_pk_bf16(o[4], o[5]); w.w = cvt_pk_bf16(o[6], o[7]);
                *(u32x4*)(act + (size_t)(row0 + ai * HALF + m * 16) * 1024 + j0) = w; }
    }
};
struct EpiDown {
    static constexpr bool PERM = true;
    bf16* ys; const float* dnb; const int* list;
    __device__ __forceinline__ void operator()(const f32x4 (&acc)[2][2][4][2], const Unit& u, int wr, int wc, int fr, int fq) const {
        const int r0 = wr * 64 + fr, col0 = u.pn * BM + wc * 32 + 8 * fq;
        const float* bp = dnb + (size_t)u.e * 1024 + col0;
        f32x4 bv[2][2];
#pragma unroll
        for (int bj = 0; bj < 2; ++bj)
#pragma unroll
            for (int n = 0; n < 2; ++n) bv[bj][n] = *(const f32x4*)(bp + bj * HALF + 4 * n);
        const int* lp = list + u.e * LISTCAP + u.mt * 256;
#pragma unroll
        for (int ai = 0; ai < 2; ++ai)
#pragma unroll
            for (int m = 0; m < 4; ++m) { const int r = r0 + ai * HALF + m * 16;
                if (r < u.rows) { const int slot = lp[r]; bf16* rowp = ys + (size_t)slot * 1024 + col0;
#pragma unroll
                    for (int bj = 0; bj < 2; ++bj) { const f32x4 v0 = acc[ai][bj][m][0] + bv[bj][0], v1 = acc[ai][bj][m][1] + bv[bj][1];
                        u32x4 w; w.x = cvt_pk_bf16(v0[0], v0[1]); w.y = cvt_pk_bf16(v0[2], v0[3]); w.z = cvt_pk_bf16(v1[0], v1[1]); w.w = cvt_pk_bf16(v1[2], v1[3]);
                        *(u32x4*)(rowp + bj * HALF) = w; } } }
    }
};
}

struct Args { const float* in[27]; const int* pos; float* out; unsigned char* ws; int ph_lo, ph_hi; };

struct Ctx {
    LAS unsigned char* lds; int tid, lane, wave, vcu, G, gw, NGW;
    unsigned char* ws;
};

DI void tr_item(const float* W, int ldw, int k0, int n0, bf16* WT, int dst_row0, LAS float* scr, int lane) {
#pragma unroll 8
    for (int i = 0; i < 32; ++i) { const int kk = 2 * i + (lane >> 5); scr[kk * 33 + (lane & 31)] = W[(size_t)(k0 + kk) * ldw + n0 + (lane & 31)]; }
    LDS_WAIT(); asm volatile("" ::: "memory");
    const int c = lane & 7;
#pragma unroll
    for (int j = 0; j < 4; ++j) { const int n = (lane >> 3) + 8 * j; const LAS float* s = scr + (8 * c) * 33 + n;
        u32x4 o; o.x = pk2(s[0 * 33], s[1 * 33]); o.y = pk2(s[2 * 33], s[3 * 33]); o.z = pk2(s[4 * 33], s[5 * 33]); o.w = pk2(s[6 * 33], s[7 * 33]);
        *(GAS u32x4*)(WT + (size_t)(dst_row0 + n) * 1024 + k0 + 8 * c) = o; }
    LDS_WAIT(); asm volatile("" ::: "memory");
}

DI void p0_prologue(const Ctx& X, const Args& a) {
    {
        LAS float* CA = (LAS float*)X.lds;
        LAS float* RED = (LAS float*)(X.lds + 32768);
        const float* c = a.in[1];
        for (int idx = X.tid; idx < 8192; idx += NTHR) { const int b = idx >> 10, d = idx & 1023; CA[d * 8 + b] = siluf_(c[idx]); }
        __syncthreads();
        float* MOD = (float*)(X.ws + WS_MOD);
        for (int g = X.vcu; g < 224; g += X.G) {
            const float* W; const float* bias; int ld, outcol;
            if (g < 96) { W = a.in[3] + 64 * g; ld = 6144; bias = a.in[4] + 64 * g; outcol = 64 * g; }
            else if (g < 192) { W = a.in[3] + (size_t)1024 * 6144 + 64 * (g - 96); ld = 6144; bias = a.in[4] + 6144 + 64 * (g - 96); outcol = 6144 + 64 * (g - 96); }
            else { W = a.in[12] + 64 * (g - 192); ld = 2048; bias = a.in[13] + 64 * (g - 192); outcol = 12288 + 64 * (g - 192); }
            float acc[8];
#pragma unroll
            for (int b = 0; b < 8; ++b) acc[b] = 0.f;
            const int d0 = X.wave * 128;
#pragma unroll 8
            for (int dd = 0; dd < 128; ++dd) { const int d = d0 + dd; const float wv = W[(size_t)d * ld + X.lane];
                const f32x4 c0 = *(const LAS f32x4*)(CA + d * 8), c1 = *(const LAS f32x4*)(CA + d * 8 + 4);
                acc[0] += c0[0] * wv; acc[1] += c0[1] * wv; acc[2] += c0[2] * wv; acc[3] += c0[3] * wv;
                acc[4] += c1[0] * wv; acc[5] += c1[1] * wv; acc[6] += c1[2] * wv; acc[7] += c1[3] * wv; }
#pragma unroll
            for (int b = 0; b < 8; ++b) RED[(X.wave * 8 + b) * 64 + X.lane] = acc[b];
            __syncthreads();
            { const int b = X.tid >> 6, col = X.tid & 63; float s = bias[col];
#pragma unroll
              for (int w = 0; w < 8; ++w) s += RED[(w * 8 + b) * 64 + col];
              MOD[(size_t)b * MODW + outcol + col] = s; }
            __syncthreads();
        }
    }
    {
        float* ROPE = (float*)(X.ws + WS_ROPE);
        for (int idx = X.gw * 64 + X.lane; idx < T * 8; idx += X.NGW * 64) {
            const int t = idx >> 3, i = idx & 7;
            const float invf = i == 0 ? 1.0f : i == 1 ? 0.19392274f : i == 2 ? 0.03760603f : i == 3 ? 0.0072926646f : i == 4 ? 0.0014142136f : i == 5 ? 0.0002742482f : i == 6 ? 5.3182957e-05f : 1.0313385e-05f;
            const float ang = (float)a.pos[t] * invf;
            double rev = (double)ang * 0.15915494309189533577; rev -= __builtin_rint(rev);
            const float fr = (float)rev;
            ROPE[t * 16 + i] = __builtin_amdgcn_cosf(fr); ROPE[t * 16 + 8 + i] = __builtin_amdgcn_sinf(fr);
        }
    }
    {
        LAS float* scr = (LAS float*)(X.lds + 65536 + X.wave * 8448);
        bf16* WIN_T = (bf16*)(X.ws + WS_WIN_T); bf16* WOUT_T = (bf16*)(X.ws + WS_WOUT_T); bf16* KV_T = (bf16*)(X.ws + WS_KV_T);
        bf16* WQ_T = (bf16*)(X.ws + WS_WQ_T); bf16* BWOUT_T = (bf16*)(X.ws + WS_BWOUT_T); bf16* UP_T = (bf16*)(X.ws + WS_UP_T); bf16* DOWN_T = (bf16*)(X.ws + WS_DOWN_T);
        constexpr int I0 = 16 * 128, I1 = 512, I2 = 16 * 8, I3 = 512, I4 = 512, I5 = 64 * 1024, I6 = 64 * 512;
        constexpr int NITEMS = I0 + I1 + I2 + I3 + I4 + I5 + I6;
        for (int it = X.gw; it < NITEMS; it += X.NGW) {
            int r = it;
            if (r < I0) { tr_item(a.in[6], 4112, 64 * (r / 128), 32 * (r % 128), WIN_T, 32 * (r % 128), scr, X.lane); continue; } r -= I0;
            if (r < I1) { tr_item(a.in[11], 1024, 64 * (r / 32), 32 * (r % 32), WOUT_T, 32 * (r % 32), scr, X.lane); continue; } r -= I1;
            if (r < I2) { tr_item(a.in[15], 256, 64 * (r / 8), 32 * (r % 8), KV_T, 32 * (r % 8), scr, X.lane); continue; } r -= I2;
            if (r < I3) { tr_item(a.in[17], 1024, 64 * (r / 32), 32 * (r % 32), WQ_T, 32 * (r % 32), scr, X.lane); continue; } r -= I3;
            if (r < I4) { tr_item(a.in[20], 1024, 64 * (r / 32), 32 * (r % 32), BWOUT_T, 32 * (r % 32), scr, X.lane); continue; } r -= I4;
            if (r < I5) { const int mi = r >> 10, rr = r & 1023, kb = rr >> 6, nb = rr & 63, n0 = 32 * nb, half = n0 >> 10, j0 = n0 & 1023;
                tr_item(a.in[23] + (size_t)mi * 1024 * 2048, 2048, 64 * kb, n0, UP_T + (size_t)mi * 2048 * 1024, (j0 >> 7) * 256 + half * 128 + (j0 & 127), scr, X.lane); continue; } r -= I5;
            { const int mi = r >> 9, rr = r & 511, kb = rr >> 5, nb = rr & 31;
                tr_item(a.in[25] + (size_t)mi * 1024 * 1024, 1024, 64 * kb, 32 * nb, DOWN_T + (size_t)mi * 1024 * 1024, 32 * nb, scr, X.lane); }
        }
    }
}

DI void load_affine(const float* gain, const float* scale, const float* shift, int lane, f32x4 (&A)[4], f32x4 (&Bv)[4]) {
#pragma unroll
    for (int j = 0; j < 4; ++j) { const int d = 4 * lane + 256 * j; const f32x4 g = *(const f32x4*)(gain + d), sc = *(const f32x4*)(scale + d); A[j] = g * (sc + 1.0f); Bv[j] = *(const f32x4*)(shift + d); }
}
DI void store_bf16_row(bf16* row, int lane, const f32x4 (&h)[4]) {
#pragma unroll
    for (int j = 0; j < 4; ++j) { u32x2 w; w.x = pk2(h[j][0], h[j][1]); w.y = pk2(h[j][2], h[j][3]); *(u32x2*)(row + 4 * lane + 256 * j) = w; }
}
DI float row_rs(const f32x4 (&v)[4]) {
    float ss = 0.f;
#pragma unroll
    for (int j = 0; j < 4; ++j) ss += (v[j][0] * v[j][0] + v[j][1] * v[j][1]) + (v[j][2] * v[j][2] + v[j][3] * v[j][3]);
    return rsqrtf(wave_sum(ss) * (1.0f / 1024.0f) + EPS);
}

DI void p1_norm1(const Ctx& X, const Args& a) {
    LAS float* WTL = (LAS float*)X.lds;
    const float* w_in = a.in[6];
    for (int idx = X.tid; idx < 16384; idx += NTHR) { const int d = idx >> 4, o = idx & 15; WTL[o * 1024 + d] = w_in[(size_t)d * 4112 + 4096 + o]; }
    __syncthreads();
    const float* MOD = (const float*)(X.ws + WS_MOD); bf16* H = (bf16*)(X.ws + WS_H); float* AB = (float*)(X.ws + WS_AB);
    for (int tb = X.gw; tb < T / 8; tb += X.NGW) {
        const int t0 = tb * 8, b = t0 / SEQ;
        f32x4 A[4], Bv[4]; load_affine(a.in[5], MOD + (size_t)b * MODW + 1024, MOD + (size_t)b * MODW, X.lane, A, Bv);
        for (int tt = 0; tt < 8; ++tt) {
            const int t = t0 + tt; const float* xr = a.in[0] + (size_t)t * D;
            f32x4 v[4];
#pragma unroll
            for (int j = 0; j < 4; ++j) v[j] = *(const f32x4*)(xr + 4 * X.lane + 256 * j);
            const float r = row_rs(v);
#pragma unroll
            for (int j = 0; j < 4; ++j) v[j] = v[j] * r * A[j] + Bv[j];
            store_bf16_row(H + (size_t)t * D, X.lane, v);
            float res = 0.f;
#pragma unroll 4
            for (int o = 0; o < 16; ++o) { float p = 0.f;
#pragma unroll
                for (int j = 0; j < 4; ++j) { const f32x4 w = *(const LAS f32x4*)(WTL + o * 1024 + 4 * X.lane + 256 * j); p += (v[j][0] * w[0] + v[j][1] * w[1]) + (v[j][2] * w[2] + v[j][3] * w[3]); }
                p = wave_sum(p); res = (X.lane == o) ? p : res; }
            if (X.lane < 16) AB[(size_t)t * 16 + X.lane] = res;
        }
    }
}

DI void p_norm_router(const Ctx& X, const Args& a, int layer, const float* xin) {
    LAS float* WTL = (LAS float*)X.lds;
    LAS int* HIST = (LAS int*)(X.lds + TAB_OFF); LAS int* BASE = HIST + 32; LAS int* ASG = HIST + 64;
    const float* rw = a.in[21] + (size_t)layer * 1024 * 32; const float* rb = a.in[22] + layer * 32;
    for (int idx = X.tid; idx < 32768; idx += NTHR) { const int d = idx >> 5, o = idx & 31; WTL[o * 1024 + d] = rw[idx]; }
    const float* MOD = (const float*)(X.ws + WS_MOD) + layer * 6144; bf16* H = (bf16*)(X.ws + WS_H);
    float* RGATE = (float*)(X.ws + WS_RGATE); int* LIST = (int*)(X.ws + WS_LIST);
    unsigned* gcnt = (unsigned*)(X.ws + WS_CTL) + CW_CNT + 64 * layer;
    const float* gain = a.in[5] + (size_t)(layer * 2 + 1) * D;
    for (int tb = X.vcu; tb < T / 64; tb += X.G) {
        if (X.tid < 32) HIST[X.tid] = 0;
        __syncthreads();
        const int t0 = tb * 64 + X.wave * 8, b = t0 / SEQ;
        f32x4 A[4], Bv[4]; load_affine(gain, MOD + (size_t)b * MODW + 4096, MOD + (size_t)b * MODW + 3072, X.lane, A, Bv);
        for (int tt = 0; tt < 8; ++tt) {
            const int t = t0 + tt; const float* xr = xin + (size_t)t * D;
            f32x4 v[4];
#pragma unroll
            for (int j = 0; j < 4; ++j) v[j] = *(const f32x4*)(xr + 4 * X.lane + 256 * j);
            const float r = row_rs(v);
#pragma unroll
            for (int j = 0; j < 4; ++j) v[j] = v[j] * r * A[j] + Bv[j];
            store_bf16_row(H + (size_t)t * D, X.lane, v);
            float lg = -3.0e38f;
#pragma unroll 4
            for (int o = 0; o < 32; ++o) { float p = 0.f;
#pragma unroll
                for (int j = 0; j < 4; ++j) { const f32x4 w = *(const LAS f32x4*)(WTL + o * 1024 + 4 * X.lane + 256 * j); p += (v[j][0] * w[0] + v[j][1] * w[1]) + (v[j][2] * w[2] + v[j][3] * w[3]); }
                p = wave_sum(p); lg = (X.lane == o) ? p : lg; }
            if (X.lane < 32) lg += rb[X.lane];
            float tv[4]; int ti[4];
#pragma unroll
            for (int k = 0; k < 4; ++k) { float best = lg; int bi = X.lane;
#pragma unroll
                for (int o = 1; o < 64; o <<= 1) { const float ov = __shfl_xor(best, o); const int oi = __shfl_xor(bi, o); if (ov > best || (ov == best && oi < bi)) { best = ov; bi = oi; } }
                tv[k] = best; ti[k] = bi; if (X.lane == bi) lg = -3.0e38f; }
            const float e1 = __expf(tv[1] - tv[0]), e2 = __expf(tv[2] - tv[0]), e3 = __expf(tv[3] - tv[0]); const float inv = 1.0f / (1.0f + e1 + e2 + e3);
            if (X.lane < 4) { const int e = X.lane == 0 ? ti[0] : X.lane == 1 ? ti[1] : X.lane == 2 ? ti[2] : ti[3];
                const float gt = (X.lane == 0 ? 1.0f : X.lane == 1 ? e1 : X.lane == 2 ? e2 : e3) * inv;
                const int lr = atomicAdd((int*)&HIST[e], 1);
                ASG[(X.wave * 8 + tt) * 4 + X.lane] = (e << 16) | lr; RGATE[(size_t)t * 4 + X.lane] = gt; }
        }
        __syncthreads();
        if (X.tid < 32) BASE[X.tid] = (int)__hip_atomic_fetch_add(gcnt + X.tid, (unsigned)HIST[X.tid], __ATOMIC_RELAXED, __HIP_MEMORY_SCOPE_AGENT);
        __syncthreads();
        if (X.tid < 256) { const int av = ASG[X.tid], e = av >> 16, lr = av & 0xffff; LIST[e * LISTCAP + BASE[e] + lr] = tb * 256 + X.tid; }
        __syncthreads();
    }
}

DI void moe_table(const Ctx& X, int layer) {
    LAS int* tab = (LAS int*)(X.lds + TAB_OFF);
    const unsigned* gcnt = (const unsigned*)(X.ws + WS_CTL) + CW_CNT + 64 * layer;
    if (X.tid < 32) tab[X.tid] = (int)__hip_atomic_load(gcnt + X.tid, __ATOMIC_RELAXED, __HIP_MEMORY_SCOPE_AGENT);
    __syncthreads();
    if (X.tid == 0) { int s = 0; for (int e = 0; e < 32; ++e) { tab[32 + e] = s; s += (tab[e] + 255) >> 8; } tab[64] = s; }
    __syncthreads();
    if (X.tid < 32) { const int s0 = tab[32 + X.tid], s1 = tab[33 + X.tid]; for (int q = s0; q < s1; ++q) tab[80 + q] = X.tid; }
    __syncthreads();
}

DI void p10_combine_norm(const Ctx& X, const Args& a) {
    const float* MOD = (const float*)(X.ws + WS_MOD); const float* X1 = (const float*)(X.ws + WS_X1); float* X2 = (float*)(X.ws + WS_X2);
    const bf16* YS = (const bf16*)(X.ws + WS_YS); const float* RGATE = (const float*)(X.ws + WS_RGATE);
    bf16* HKV = (bf16*)(X.ws + WS_HKV); bf16* HQ = (bf16*)(X.ws + WS_HQ);
    for (int tb = X.gw; tb < T / 8; tb += X.NGW) {
        const int t0 = tb * 8, b = t0 / SEQ; const float* mb = MOD + (size_t)b * MODW;
        f32x4 G2[4], Ak[4], Bk[4], Aq[4], Bq[4];
#pragma unroll
        for (int j = 0; j < 4; ++j) G2[j] = *(const f32x4*)(mb + 5120 + 4 * X.lane + 256 * j);
        load_affine(a.in[14], mb + 12288 + 1024, mb + 12288, X.lane, Ak, Bk);
        load_affine(a.in[5] + 2 * D, mb + 6144 + 1024, mb + 6144, X.lane, Aq, Bq);
        for (int tt = 0; tt < 8; ++tt) {
            const int t = t0 + tt;
            const f32x4 gt = *(const f32x4*)(RGATE + (size_t)t * 4);
            f32x4 v[4];
#pragma unroll
            for (int j = 0; j < 4; ++j) { const int d = 4 * X.lane + 256 * j; f32x4 s = (f32x4){0.f, 0.f, 0.f, 0.f};
#pragma unroll
                for (int k = 0; k < 4; ++k) { const u32x2 w = *(const u32x2*)(YS + ((size_t)t * 4 + k) * 1024 + d); const float g = gt[k];
                    s[0] += g * bflo(w.x); s[1] += g * bfhi(w.x); s[2] += g * bflo(w.y); s[3] += g * bfhi(w.y); }
                v[j] = *(const f32x4*)(X1 + (size_t)t * D + d) + G2[j] * s; *(f32x4*)(X2 + (size_t)t * D + d) = v[j]; }
            const float r = row_rs(v);
            f32x4 h[4];
#pragma unroll
            for (int j = 0; j < 4; ++j) h[j] = v[j] * r * Ak[j] + Bk[j];
            store_bf16_row(HKV + (size_t)t * D, X.lane, h);
#pragma unroll
            for (int j = 0; j < 4; ++j) h[j] = v[j] * r * Aq[j] + Bq[j];
            store_bf16_row(HQ + (size_t)t * D, X.lane, h);
        }
    }
}
DI void p18_final(const Ctx& X, const Args& a) {
    const float* MOD = (const float*)(X.ws + WS_MOD); const float* X3 = (const float*)(X.ws + WS_X1);
    const bf16* YS = (const bf16*)(X.ws + WS_YS); const float* RGATE = (const float*)(X.ws + WS_RGATE);
    for (int tb = X.gw; tb < T / 8; tb += X.NGW) {
        const int t0 = tb * 8, b = t0 / SEQ; const float* mb = MOD + (size_t)b * MODW + 6144;
        f32x4 G2[4];
#pragma unroll
        for (int j = 0; j < 4; ++j) G2[j] = *(const f32x4*)(mb + 5120 + 4 * X.lane + 256 * j);
        for (int tt = 0; tt < 8; ++tt) {
            const int t = t0 + tt;
            const f32x4 gt = *(const f32x4*)(RGATE + (size_t)t * 4);
#pragma unroll
            for (int j = 0; j < 4; ++j) { const int d = 4 * X.lane + 256 * j; f32x4 s = (f32x4){0.f, 0.f, 0.f, 0.f};
#pragma unroll
                for (int k = 0; k < 4; ++k) { const u32x2 w = *(const u32x2*)(YS + ((size_t)t * 4 + k) * 1024 + d); const float g = gt[k];
                    s[0] += g * bflo(w.x); s[1] += g * bfhi(w.x); s[2] += g * bflo(w.y); s[3] += g * bfhi(w.y); }
                *(f32x4*)(a.out + (size_t)t * D + d) = *(const f32x4*)(X3 + (size_t)t * D + d) + G2[j] * s; }
        }
    }
}

DI void unpack16(const u32x4 a, const u32x4 b, float (&f)[16]) {
    f[0] = bflo(a.x); f[1] = bfhi(a.x); f[2] = bflo(a.y); f[3] = bfhi(a.y); f[4] = bflo(a.z); f[5] = bfhi(a.z); f[6] = bflo(a.w); f[7] = bfhi(a.w);
    f[8] = bflo(b.x); f[9] = bfhi(b.x); f[10] = bflo(b.y); f[11] = bfhi(b.y); f[12] = bflo(b.z); f[13] = bfhi(b.z); f[14] = bflo(b.w); f[15] = bfhi(b.w);
}
DI void store16(bf16* p, const float (&f)[16]) {
    u32x4 a, b; a.x = pk2(f[0], f[1]); a.y = pk2(f[2], f[3]); a.z = pk2(f[4], f[5]); a.w = pk2(f[6], f[7]); b.x = pk2(f[8], f[9]); b.y = pk2(f[10], f[11]); b.z = pk2(f[12], f[13]); b.w = pk2(f[14], f[15]);
    *(u32x4*)p = a; *(u32x4*)(p + 8) = b;
}
DI void p5_onorm(const Ctx& X, const Args& a) {
    const bf16* O = (const bf16*)(X.ws + WS_O); const bf16* PROJ = (const bf16*)(X.ws + WS_PROJ); bf16* ON = (bf16*)(X.ws + WS_ON);
    float og[16];
#pragma unroll
    for (int i = 0; i < 16; ++i) og[i] = a.in[10][(16 * X.lane + i) & 127];
    for (int t = X.gw; t < T; t += X.NGW) {
        float o[16], z[16];
        unpack16(*(const u32x4*)(O + (size_t)t * D + 16 * X.lane), *(const u32x4*)(O + (size_t)t * D + 16 * X.lane + 8), o);
        unpack16(*(const u32x4*)(PROJ + (size_t)t * 4096 + 3072 + 16 * X.lane), *(const u32x4*)(PROJ + (size_t)t * 4096 + 3072 + 16 * X.lane + 8), z);
        float ss = 0.f;
#pragma unroll
        for (int i = 0; i < 16; ++i) ss += o[i] * o[i];
        ss += __shfl_xor(ss, 1); ss += __shfl_xor(ss, 2); ss += __shfl_xor(ss, 4);
        const float r = rsqrtf(ss * (1.0f / 128.0f) + EPS);
#pragma unroll
        for (int i = 0; i < 16; ++i) o[i] = o[i] * r * og[i] * siluf_(z[i]);
        store16(ON + (size_t)t * D + 16 * X.lane, o);
    }
}

DI void p12_qknorm(const Ctx& X, const Args& a) {
    const bf16* QKV = (const bf16*)(X.ws + WS_QKV); const float* ROPE = (const float*)(X.ws + WS_ROPE);
    bf16* QN = (bf16*)(X.ws + WS_QN); bf16* KN = (bf16*)(X.ws + WS_KN); bf16* VT = (bf16*)(X.ws + WS_VT);
    float qg[16], kg[16];
#pragma unroll
    for (int i = 0; i < 16; ++i) { qg[i] = a.in[18][(16 * X.lane + i) & 63]; kg[i] = a.in[16][(16 * X.lane + i) & 63]; }
    for (int t = X.gw; t < T; t += X.NGW) {
        const int b = t / SEQ, s = t % SEQ;
        float cs[8], sn[8];
        { const f32x4 c0 = *(const f32x4*)(ROPE + (size_t)t * 16), c1 = *(const f32x4*)(ROPE + (size_t)t * 16 + 4), s0 = *(const f32x4*)(ROPE + (size_t)t * 16 + 8), s1 = *(const f32x4*)(ROPE + (size_t)t * 16 + 12);
#pragma unroll
          for (int i = 0; i < 4; ++i) { cs[i] = c0[i]; cs[4 + i] = c1[i]; sn[i] = s0[i]; sn[4 + i] = s1[i]; } }
        float q[16];
        unpack16(*(const u32x4*)(QKV + (size_t)t * 1280 + 256 + 16 * X.lane), *(const u32x4*)(QKV + (size_t)t * 1280 + 256 + 16 * X.lane + 8), q);
        float ss = 0.f;
#pragma unroll
        for (int i = 0; i < 16; ++i) ss += q[i] * q[i];
        ss += __shfl_xor(ss, 1); ss += __shfl_xor(ss, 2);
        float r = rsqrtf(ss * (1.0f / 64.0f) + EPS);
#pragma unroll
        for (int i = 0; i < 16; ++i) q[i] = q[i] * r * qg[i];
        if ((X.lane & 3) == 0) {
#pragma unroll
            for (int i = 0; i < 8; ++i) { const float x1 = q[i], x2 = q[8 + i]; q[i] = x1 * cs[i] - x2 * sn[i]; q[8 + i] = x2 * cs[i] + x1 * sn[i]; } }
#pragma unroll
        for (int i = 0; i < 16; ++i) q[i] *= 0.125f;
        store16(QN + (size_t)t * D + 16 * X.lane, q);
        if (X.lane < 8) {
            float k[16], v[16];
            unpack16(*(const u32x4*)(QKV + (size_t)t * 1280 + 16 * X.lane), *(const u32x4*)(QKV + (size_t)t * 1280 + 16 * X.lane + 8), k);
            unpack16(*(const u32x4*)(QKV + (size_t)t * 1280 + 128 + 16 * X.lane), *(const u32x4*)(QKV + (size_t)t * 1280 + 128 + 16 * X.lane + 8), v);
            float s2 = 0.f;
#pragma unroll
            for (int i = 0; i < 16; ++i) s2 += k[i] * k[i];
            s2 += __shfl_xor(s2, 1); s2 += __shfl_xor(s2, 2);
            r = rsqrtf(s2 * (1.0f / 64.0f) + EPS);
#pragma unroll
            for (int i = 0; i < 16; ++i) k[i] = k[i] * r * kg[i];
            if ((X.lane & 3) == 0) {
#pragma unroll
                for (int i = 0; i < 8; ++i) { const float x1 = k[i], x2 = k[8 + i]; k[i] = x1 * cs[i] - x2 * sn[i]; k[8 + i] = x2 * cs[i] + x1 * sn[i]; } }
            const int kvh = X.lane >> 2, d0 = (16 * X.lane) & 63;
            store16(KN + ((size_t)(b * 2 + kvh) * SEQ + s) * 64 + d0, k);
#pragma unroll
            for (int i = 0; i < 16; ++i) VT[((size_t)(b * 2 + kvh) * 64 + d0 + i) * SEQ + s] = (bf16)f2bf(v[i]);
        }
    }
}

constexpr int PS = 132;
constexpr int PB = 136;
DI void p3_prep(const Ctx& X, const Args& a) {
    LAS float* KS = (LAS float*)X.lds; LAS float* VS = KS + 64 * PS; LAS float* QS = VS + 64 * PS;
    LAS float* AM = QS;
    LAS bf16* QB = (LAS bf16*)(X.lds + 3 * 33792); LAS bf16* KBb = QB + 64 * PB;
    LAS float* GC = (LAS float*)(X.lds + 3 * 33792 + 2 * 17408); LAS float* BETA = GC + 64; LAS float* EG = GC + 128;
    const bf16* PROJ = (const bf16*)(X.ws + WS_PROJ); const float* AB = (const float*)(X.ws + WS_AB);
    float* UT = (float*)(X.ws + WS_UT); bf16* WNEG = (bf16*)(X.ws + WS_WNEG); bf16* QD = (bf16*)(X.ws + WS_QD); bf16* KTT = (bf16*)(X.ws + WS_KTT); bf16* QKG = (bf16*)(X.ws + WS_QK);
    float* GTOT = (float*)(X.ws + WS_GTOT);
    const float* convw = a.in[7];
    const int fr_ = X.lane & 15, fq_ = X.lane >> 4;
    for (int cid = X.vcu; cid < NB * AH * NCH; cid += X.G) {
        const int b = cid >> 8, h = (cid >> 5) & 7, n = cid & 31, t0 = b * SEQ + n * 64;
        int fr = fr_, fq = fq_; asm volatile("" : "+v"(fr), "+v"(fq));
        const size_t rowbase = (size_t)(b * 8 + h) * SEQ + n * 64;
        if (X.tid < 384) {
            const int which = X.tid >> 7, col = X.tid & 127, ch = which * 1024 + h * 128 + col;
            const float w0 = convw[ch], w1 = convw[3072 + ch], w2 = convw[2 * 3072 + ch], w3 = convw[3 * 3072 + ch];
            const bf16* src = PROJ + (size_t)t0 * 4096 + ch;
            float xm3 = 0.f, xm2 = 0.f, xm1 = 0.f;
            if (n > 0) { xm3 = bf2f(src[-3 * 4096]); xm2 = bf2f(src[-2 * 4096]); xm1 = bf2f(src[-1 * 4096]); }
            LAS float* dst = (which == 0 ? QS : which == 1 ? KS : VS) + col;
#pragma unroll 8
            for (int i = 0; i < 64; ++i) { const float xi = bf2f(src[(size_t)i * 4096]); const float y = w0 * xm3 + w1 * xm2 + w2 * xm1 + w3 * xi;
                dst[i * PS] = siluf_(y); xm3 = xm2; xm2 = xm1; xm1 = xi; }
        } else if (X.tid < 448) {
            const int i = X.tid - 384;
            const float av = AB[(size_t)(t0 + i) * 16 + h], bv = AB[(size_t)(t0 + i) * 16 + 8 + h];
            const float xx = av + a.in[9][h]; const float sp = xx > 20.f ? xx : log1pf(__expf(xx));
            float g = -__expf(a.in[8][h]) * sp;
#pragma unroll
            for (int o = 1; o < 64; o <<= 1) { const float up = __shfl_up(g, o); if (i >= o) g += up; }
            GC[i] = g; BETA[i] = sigmoidf_(bv); EG[i] = __expf(g);
            if (i == 63) GTOT[cid] = __expf(g);
        }
        __syncthreads();
        {
            const float gl = GC[63];
            for (int rr = 0; rr < 16; ++rr) { const int row = X.wave * 16 + rr, i = row & 63; const bool isq = row < 64;
                LAS float* src = (isq ? QS : KS) + i * PS + 2 * X.lane;
                float v0 = src[0], v1 = src[1];
                const float ss = wave_sum(v0 * v0 + v1 * v1);
                const float r = rsqrtf(ss + EPS) * (isq ? 0.08838834764831845f : 1.0f);
                v0 *= r; v1 *= r;
                if (isq) { *(LAS unsigned*)(QB + i * PB + 2 * X.lane) = pk2(v0, v1); const float eg = EG[i];
                    *(unsigned*)(QD + (rowbase + i) * 128 + 2 * X.lane) = pk2(v0 * eg, v1 * eg); }
                else { *(LAS unsigned*)(KBb + i * PB + 2 * X.lane) = pk2(v0, v1); src[0] = v0; src[1] = v1; }
            }
            (void)gl;
        }
        __syncthreads();
#pragma unroll
        for (int q4 = 0; q4 < 4; ++q4) { const int tt = X.wave * 4 + q4, isqk = tt >> 4, it = (tt & 15) >> 2, jt = tt & 3;
            f32x4 acc = (f32x4){0.f, 0.f, 0.f, 0.f};
            if (it >= jt) {
                const LAS bf16* Ap = (isqk ? QB : KBb) + (16 * it + fr) * PB + fq * 8; const LAS bf16* Bp = KBb + (16 * jt + fr) * PB + fq * 8;
#pragma unroll
                for (int kk = 0; kk < 4; ++kk) acc = MFMA16(*(const LAS bf16x8*)(Ap + kk * 32), *(const LAS bf16x8*)(Bp + kk * 32), acc);
            }
            const int j = 16 * jt + fr; const float gj = GC[j];
            f32x4 av;
#pragma unroll
            for (int r = 0; r < 4; ++r) { const int i = 16 * it + fq * 4 + r; const float dec = __expf(fminf(GC[i] - gj, 0.f));
                if (isqk) { const float v = (i >= j) ? acc[r] * dec : 0.f; QKG[(size_t)cid * 4096 + i * 64 + j] = (bf16)f2bf(v); }
                else av[r] = (i > j) ? acc[r] * dec * BETA[i] : 0.f; }
            if (!isqk) *(LAS f32x4*)(AM + j * 68 + 16 * it + fq * 4) = av;
        }
        { const int d = X.tid >> 2, jh = (X.tid & 3) * 16; const float gl = GC[63];
            unsigned w[8];
#pragma unroll
            for (int jj = 0; jj < 8; ++jj) { const int j0 = jh + 2 * jj; w[jj] = pk2(KS[j0 * PS + d] * __expf(gl - GC[j0]), KS[(j0 + 1) * PS + d] * __expf(gl - GC[j0 + 1])); }
            bf16* kp = KTT + (size_t)cid * 8192 + d * 64 + jh;
            *(u32x4*)kp = (u32x4){w[0], w[1], w[2], w[3]}; *(u32x4*)(kp + 8) = (u32x4){w[4], w[5], w[6], w[7]}; }
        __syncthreads();
        if (X.tid < 256) {
            const int c = X.tid; const bool isu = c < 128; LAS float* col = (isu ? VS : KS) + (c & 127);
#pragma unroll
            for (int kb = 0; kb < 4; ++kb) {
                float r[16];
#pragma unroll
                for (int ii = 0; ii < 16; ++ii) { const int i = 16 * kb + ii; r[ii] = col[i * PS] * BETA[i]; if (!isu) r[ii] *= EG[i]; }
                for (int j = 0; j < 16 * kb; ++j) { const float s = col[j * PS];
                    const f32x4 a0 = *(const LAS f32x4*)(AM + j * 68 + 16 * kb), a1 = *(const LAS f32x4*)(AM + j * 68 + 16 * kb + 4), a2 = *(const LAS f32x4*)(AM + j * 68 + 16 * kb + 8), a3 = *(const LAS f32x4*)(AM + j * 68 + 16 * kb + 12);
#pragma unroll
                    for (int q = 0; q < 4; ++q) { r[q] -= a0[q] * s; r[4 + q] -= a1[q] * s; r[8 + q] -= a2[q] * s; r[12 + q] -= a3[q] * s; } }
#pragma unroll
                for (int jj = 0; jj < 15; ++jj) { const LAS float* ar = AM + (16 * kb + jj) * 68 + 16 * kb;
                    const f32x4 a0 = *(const LAS f32x4*)(ar), a1 = *(const LAS f32x4*)(ar + 4), a2 = *(const LAS f32x4*)(ar + 8), a3 = *(const LAS f32x4*)(ar + 12);
                    const float s = r[jj];
#pragma unroll
                    for (int q = 0; q < 4; ++q) { if (q > jj) r[q] -= a0[q] * s; if (4 + q > jj) r[4 + q] -= a1[q] * s; if (8 + q > jj) r[8 + q] -= a2[q] * s; if (12 + q > jj) r[12 + q] -= a3[q] * s; }
                    asm volatile("" ::: "memory"); }
#pragma unroll
                for (int ii = 0; ii < 16; ++ii) col[(16 * kb + ii) * PS] = r[ii];
                if (isu) { float* up = UT + (size_t)cid * 8192 + c * 64 + 16 * kb;
#pragma unroll
                    for (int ii = 0; ii < 16; ii += 4) *(f32x4*)(up + ii) = (f32x4){r[ii], r[ii + 1], r[ii + 2], r[ii + 3]}; }
                else { bf16* wp = WNEG + (rowbase + 16 * kb) * 128 + (c - 128);
#pragma unroll
                    for (int ii = 0; ii < 16; ++ii) wp[(size_t)ii * 128] = (bf16)f2bf(-r[ii]); }
            }
        }
        __syncthreads();
    }
}

DI void p4_scan(const Ctx& X, const Args& a) {
    LAS bf16* SL = (LAS bf16*)X.lds;
    LAS bf16* VL = (LAS bf16*)(X.lds + 32 * 136 * 2);
    const float* UT = (const float*)(X.ws + WS_UT); const bf16* WNEG = (const bf16*)(X.ws + WS_WNEG); const bf16* QD = (const bf16*)(X.ws + WS_QD);
    const bf16* KTT = (const bf16*)(X.ws + WS_KTT); const bf16* QKG = (const bf16*)(X.ws + WS_QK); const float* GTOT = (const float*)(X.ws + WS_GTOT);
    bf16* O = (bf16*)(X.ws + WS_O);
    const int fr = X.lane & 15, fq = X.lane >> 4, w = X.wave, et = w & 1, jt = w >> 1;
    for (int unit = X.vcu; unit < NB * AH * 4; unit += X.G) {
        const int bh = unit >> 2, sl = unit & 3, b = bh >> 3, h = bh & 7;
        f32x4 S0 = (f32x4){0.f, 0.f, 0.f, 0.f}, S1 = S0;
        for (int n = 0; n < NCH; ++n) {
            const int cid = bh * 32 + n; const size_t rowbase = (size_t)bh * SEQ + n * 64;
            bf16x8 wn[4], qd[4], qk[2], kt[2];
#pragma unroll
            for (int kk = 0; kk < 4; ++kk) { wn[kk] = *(const bf16x8*)(WNEG + (rowbase + 16 * jt + fr) * 128 + kk * 32 + fq * 8); qd[kk] = *(const bf16x8*)(QD + (rowbase + 16 * jt + fr) * 128 + kk * 32 + fq * 8); }
#pragma unroll
            for (int k2 = 0; k2 < 2; ++k2) { qk[k2] = *(const bf16x8*)(QKG + (size_t)cid * 4096 + (16 * jt + fr) * 64 + k2 * 32 + fq * 8); kt[k2] = *(const bf16x8*)(KTT + (size_t)cid * 8192 + (16 * w + fr) * 64 + k2 * 32 + fq * 8); }
            f32x4 v = *(const f32x4*)(UT + (size_t)cid * 8192 + (sl * 32 + 16 * et + fr) * 64 + 16 * jt + 4 * fq);
            const float gt = GTOT[cid];
            { u32x2 p0, p1; p0.x = pk2(S0[0], S0[1]); p0.y = pk2(S0[2], S0[3]); p1.x = pk2(S1[0], S1[1]); p1.y = pk2(S1[2], S1[3]);
              *(LAS u32x2*)(SL + fr * 136 + 16 * w + 4 * fq) = p0; *(LAS u32x2*)(SL + (16 + fr) * 136 + 16 * w + 4 * fq) = p1; }
            __syncthreads();
            f32x4 o = (f32x4){0.f, 0.f, 0.f, 0.f};
#pragma unroll
            for (int kk = 0; kk < 4; ++kk) { const bf16x8 sf = *(const LAS bf16x8*)(SL + (16 * et + fr) * 136 + kk * 32 + fq * 8);
                v = MFMA16(wn[kk], sf, v); o = MFMA16(sf, qd[kk], o); }
            { u32x2 p; p.x = pk2(v[0], v[1]); p.y = pk2(v[2], v[3]); *(LAS u32x2*)(VL + (16 * et + fr) * 72 + 16 * jt + 4 * fq) = p; }
            __syncthreads();
#pragma unroll
            for (int r = 0; r < 4; ++r) { S0[r] *= gt; S1[r] *= gt; }
#pragma unroll
            for (int k2 = 0; k2 < 2; ++k2) { const bf16x8 v0 = *(const LAS bf16x8*)(VL + fr * 72 + k2 * 32 + fq * 8), v1 = *(const LAS bf16x8*)(VL + (16 + fr) * 72 + k2 * 32 + fq * 8);
                o = MFMA16(et ? v1 : v0, qk[k2], o); S0 = MFMA16(kt[k2], v0, S0); S1 = MFMA16(kt[k2], v1, S1); }
            { u32x2 p; p.x = pk2(o[0], o[1]); p.y = pk2(o[2], o[3]);
              *(u32x2*)(O + (size_t)(b * SEQ + n * 64 + 16 * jt + fr) * D + h * 128 + sl * 32 + 16 * et + 4 * fq) = p; }
        }
        __syncthreads();
    }
}

DI void p13_attn(const Ctx& X, const Args& a) {
    LAS bf16* KL = (LAS bf16*)X.lds;
    LAS bf16* VTL = (LAS bf16*)(X.lds + 256 * 72 * 2);
    const bf16* QN = (const bf16*)(X.ws + WS_QN); const bf16* KN = (const bf16*)(X.ws + WS_KN); const bf16* VT = (const bf16*)(X.ws + WS_VT);
    bf16* O = (bf16*)(X.ws + WS_O);
    const int fr = X.lane & 15, fq = X.lane >> 4;
    for (int unit = X.vcu; unit < NB * 2 * 16; unit += X.G) {
        const int b = unit >> 5, kvh = (unit >> 4) & 1, blk = unit & 15, s0 = blk * 128;
        __syncthreads();
        for (int idx = X.tid; idx < 256 * 8; idx += NTHR) { const int key = idx >> 3, c8 = idx & 7; const int s = s0 - 128 + key;
            u32x4 val = (u32x4){0u, 0u, 0u, 0u};
            if (s >= 0) val = *(const u32x4*)(KN + ((size_t)(b * 2 + kvh) * SEQ + s) * 64 + c8 * 8);
            *(LAS u32x4*)(KL + key * 72 + c8 * 8) = val; }
        for (int idx = X.tid; idx < 64 * 32; idx += NTHR) { const int d = idx >> 5, c8 = idx & 31; const int s = s0 - 128 + c8 * 8;
            u32x4 val = (u32x4){0u, 0u, 0u, 0u};
            if (s >= 0) val = *(const u32x4*)(VT + ((size_t)(b * 2 + kvh) * 64 + d) * SEQ + s);
            *(LAS u32x4*)(VTL + d * 264 + c8 * 8) = val; }
        __syncthreads();
        const int head = kvh * 8 + X.wave; const float sink = a.in[19][head];
        for (int qt = 0; qt < 8; ++qt) {
            const int tq = b * SEQ + s0 + 16 * qt + fr;
            bf16x8 qf[2];
#pragma unroll
            for (int kk = 0; kk < 2; ++kk) qf[kk] = *(const bf16x8*)(QN + (size_t)tq * D + head * 64 + kk * 32 + fq * 8);
            f32x4 st[10];
            float mx = sink;
            const int iq = 16 * qt + fr;
#pragma unroll
            for (int kt = 0; kt < 10; ++kt) { const int ktile = qt + kt, kc = ktile < 15 ? ktile : 15;
                f32x4 acc = (f32x4){0.f, 0.f, 0.f, 0.f};
#pragma unroll
                for (int kk = 0; kk < 2; ++kk) acc = MFMA16(*(const LAS bf16x8*)(KL + (16 * kc + fr) * 72 + kk * 32 + fq * 8), qf[kk], acc);
#pragma unroll
                for (int r = 0; r < 4; ++r) { const int jb = 16 * ktile + 4 * fq + r; const bool ok = (jb > iq) && (jb <= iq + 128) && (blk > 0 || jb >= 128);
                    acc[r] = ok ? acc[r] : -3.0e38f; mx = fmaxf(mx, acc[r]); }
                st[kt] = acc; }
            mx = fmaxf(mx, __shfl_xor(mx, 16)); mx = fmaxf(mx, __shfl_xor(mx, 32));
            float den = 0.f;
#pragma unroll
            for (int kt = 0; kt < 10; ++kt)
#pragma unroll
                for (int r = 0; r < 4; ++r) { const float p = st[kt][r] > -1.0e38f ? __expf(st[kt][r] - mx) : 0.f; st[kt][r] = p; den += p; }
            den += __shfl_xor(den, 16); den += __shfl_xor(den, 32);
            den += __expf(sink - mx);
            const float inv = 1.0f / den;
            f32x4 o[4];
#pragma unroll
            for (int dt = 0; dt < 4; ++dt) o[dt] = (f32x4){0.f, 0.f, 0.f, 0.f};
#pragma unroll
            for (int m = 0; m < 5; ++m) { const int kt0 = qt + 2 * m, kc0 = kt0 < 15 ? kt0 : 15, kc1 = (kt0 + 1) < 15 ? (kt0 + 1) : 15;
                u32x4 pw; pw.x = pk2(st[2 * m][0], st[2 * m][1]); pw.y = pk2(st[2 * m][2], st[2 * m][3]); pw.z = pk2(st[2 * m + 1][0], st[2 * m + 1][1]); pw.w = pk2(st[2 * m + 1][2], st[2 * m + 1][3]);
                const bf16x8 pf = __builtin_bit_cast(bf16x8, pw);
#pragma unroll
                for (int dt = 0; dt < 4; ++dt) { const u32x2 va = *(const LAS u32x2*)(VTL + (16 * dt + fr) * 264 + 16 * kc0 + 4 * fq), vb = *(const LAS u32x2*)(VTL + (16 * dt + fr) * 264 + 16 * kc1 + 4 * fq);
                    const u32x4 vw = (u32x4){va.x, va.y, vb.x, vb.y};
                    o[dt] = MFMA16(__builtin_bit_cast(bf16x8, vw), pf, o[dt]); } }
#pragma unroll
            for (int dt = 0; dt < 4; ++dt) { u32x2 p; p.x = pk2(o[dt][0] * inv, o[dt][1] * inv); p.y = pk2(o[dt][2] * inv, o[dt][3] * inv);
                *(u32x2*)(O + (size_t)tq * D + head * 64 + 16 * dt + 4 * fq) = p; }
        }
    }
}

constexpr int NPH = 19;
#ifndef N_LAUNCHES
#define N_LAUNCHES 1
#endif
__global__ void __launch_bounds__(NTHR, 2) fwd_kernel(Args args) {
    extern __shared__ __attribute__((aligned(16))) unsigned char lds_raw[];
    Ctx X;
    X.lds = (LAS unsigned char*)lds_raw;
    X.tid = threadIdx.x; X.lane = X.tid & 63; X.wave = __builtin_amdgcn_readfirstlane(X.tid >> 6);
    X.G = gridDim.x; { const int bx = blockIdx.x; X.vcu = (X.G % 8 == 0) ? (bx % 8) * (X.G / 8) + bx / 8 : bx; }
    X.gw = X.vcu * NWAVES + X.wave; X.NGW = X.G * NWAVES;
    X.ws = args.ws;
    volatile LAS unsigned* MISC = (volatile LAS unsigned*)(X.lds + MISC_OFF);
    if (X.tid < 64) MISC[X.tid] = 0u;
    __syncthreads();
    unsigned* ctl = (unsigned*)(X.ws + WS_CTL);
    XcdBarrier bar; bar.bar = ctl + CW_BAR; bar.x = 0; bar.st = nullptr;
    if (N_LAUNCHES == 1) bar = xcd_barrier_post(ctl + CW_BAR, MISC + 8);
    const int lo = args.ph_lo, hi = args.ph_hi;
#define IN(k) (lo <= (k) && (k) < hi)
#define SEAM(k) do { if (IN(k) && IN((k) + 1)) xcd_barrier(bar); } while (0)
    const Args& a = args;
    bf16* H = (bf16*)(X.ws + WS_H);
    const float* MOD = (const float*)(X.ws + WS_MOD);

    if (IN(0)) { p0_prologue(X, a); } SEAM(0);
    if (IN(1)) { p1_norm1(X, a); } SEAM(1);
    if (IN(2)) {
        pg8::PlainSched S{H, (const bf16*)(X.ws + WS_WIN_T), 64, 16, X.G, (int)blockIdx.x};
        pg8::EpiBf16 E{(bf16*)(X.ws + WS_PROJ), 4096};
        pg8::gemm_phase(X.lds, S, E);
    } SEAM(2);
    if (IN(3)) { p3_prep(X, a); } SEAM(3);
    if (IN(4)) { p4_scan(X, a); } SEAM(4);
    if (IN(5)) { p5_onorm(X, a); } SEAM(5);
    if (IN(6)) {
        pg8::PlainSched S{(const bf16*)(X.ws + WS_ON), (const bf16*)(X.ws + WS_WOUT_T), 64, 4, X.G, (int)blockIdx.x};
        pg8::EpiResid E{a.in[0], (float*)(X.ws + WS_X1), MOD + 2048};
        pg8::gemm_phase(X.lds, S, E);
    } SEAM(6);
    if (IN(7)) { p_norm_router(X, a, 0, (const float*)(X.ws + WS_X1)); } SEAM(7);
    if (IN(8)) {
        moe_table(X, 0);
        pg8::MoeSched<8, true> S{H, (const bf16*)(X.ws + WS_UP_T), (const int*)(X.ws + WS_LIST), (const LAS int*)(X.lds + TAB_OFF), X.G, X.vcu, (size_t)2048 * 1024};
        pg8::EpiSwiglu E{(bf16*)(X.ws + WS_ACT), a.in[24]};
        pg8::gemm_phase(X.lds, S, E);
    } SEAM(8);
    if (IN(9)) {
        moe_table(X, 0);
        pg8::MoeSched<4, false> S{(const bf16*)(X.ws + WS_ACT), (const bf16*)(X.ws + WS_DOWN_T), (const int*)(X.ws + WS_LIST), (const LAS int*)(X.lds + TAB_OFF), X.G, X.vcu, (size_t)1024 * 1024};
        pg8::EpiDown E{(bf16*)(X.ws + WS_YS), a.in[26], (const int*)(X.ws + WS_LIST)};
        pg8::gemm_phase(X.lds, S, E);
    } SEAM(9);
    if (IN(10)) { p10_combine_norm(X, a); } SEAM(10);
    if (IN(11)) {
        pg8::KvqSched S{(const bf16*)(X.ws + WS_HKV), (const bf16*)(X.ws + WS_HQ), (const bf16*)(X.ws + WS_KV_T), (const bf16*)(X.ws + WS_WQ_T), X.G, X.vcu};
        pg8::EpiBf16 E{(bf16*)(X.ws + WS_QKV), 1280};
        pg8::gemm_phase(X.lds, S, E);
    } SEAM(11);
    if (IN(12)) { p12_qknorm(X, a); } SEAM(12);
    if (IN(13)) { p13_attn(X, a); } SEAM(13);
    if (IN(14)) {
        pg8::PlainSched S{(const bf16*)(X.ws + WS_O), (const bf16*)(X.ws + WS_BWOUT_T), 64, 4, X.G, (int)blockIdx.x};
        pg8::EpiResid E{(const float*)(X.ws + WS_X2), (float*)(X.ws + WS_X1), MOD + 6144 + 2048};
        pg8::gemm_phase(X.lds, S, E);
    } SEAM(14);
    if (IN(15)) { p_norm_router(X, a, 1, (const float*)(X.ws + WS_X1)); } SEAM(15);
    if (IN(16)) {
        moe_table(X, 1);
        pg8::MoeSched<8, true> S{H, (const bf16*)(X.ws + WS_UP_T) + (size_t)32 * 2048 * 1024, (const int*)(X.ws + WS_LIST), (const LAS int*)(X.lds + TAB_OFF), X.G, X.vcu, (size_t)2048 * 1024};
        pg8::EpiSwiglu E{(bf16*)(X.ws + WS_ACT), a.in[24] + 32 * 2048};
        pg8::gemm_phase(X.lds, S, E);
    } SEAM(16);
    if (IN(17)) {
        moe_table(X, 1);
        pg8::MoeSched<4, false> S{(const bf16*)(X.ws + WS_ACT), (const bf16*)(X.ws + WS_DOWN_T) + (size_t)32 * 1024 * 1024, (const int*)(X.ws + WS_LIST), (const LAS int*)(X.lds + TAB_OFF), X.G, X.vcu, (size_t)1024 * 1024};
        pg8::EpiDown E{(bf16*)(X.ws + WS_YS), a.in[26] + 32 * 1024, (const int*)(X.ws + WS_LIST)};
        pg8::gemm_phase(X.lds, S, E);
    } SEAM(17);
    if (IN(18)) { p18_final(X, a); }
#undef IN
#undef SEAM
}

extern "C" void kernel_launch(void* const* d_in, const int* in_sizes, int n_in, void* d_out, int out_size, void* d_ws, size_t ws_size, hipStream_t stream) {
    static int grid = 0;
    if (grid == 0) {
        if (n_in != 27 || out_size != T * D || ws_size < WS_END) { fprintf(stderr, "kernel_launch: unexpected problem (n_in %d, out %d, ws %zu)\n", n_in, out_size, ws_size); grid = -1; return; }
        int dev = 0, cus = 0, per_cu = 0;
        if (hipGetDevice(&dev) != hipSuccess || hipDeviceGetAttribute(&cus, hipDeviceAttributeMultiprocessorCount, dev) != hipSuccess) { grid = -1; return; }
        if (hipFuncSetAttribute((const void*)fwd_kernel, hipFuncAttributeMaxDynamicSharedMemorySize, LDS_BYTES) != hipSuccess) { fprintf(stderr, "kernel_launch: hipFuncSetAttribute failed\n"); grid = -1; return; }
        if (hipOccupancyMaxActiveBlocksPerMultiprocessor(&per_cu, (const void*)fwd_kernel, NTHR, LDS_BYTES) != hipSuccess || per_cu < 1) { fprintf(stderr, "kernel_launch: occupancy query says %d\n", per_cu); (void)hipGetLastError(); }
        grid = cus;
    }
    if (grid < 0) return;
    (void)hipMemsetAsync((char*)d_ws + WS_CTL, 0, CTL_ZERO_BYTES, stream);
    Args a{};
    for (int i = 0; i < 27; ++i) a.in[i] = (const float*)d_in[i];
    a.pos = (const int*)d_in[2]; a.out = (float*)d_out; a.ws = (unsigned char*)d_ws;
    if (N_LAUNCHES == 1) { a.ph_lo = 0; a.ph_hi = NPH; hipLaunchKernelGGL(fwd_kernel, dim3(grid), dim3(NTHR), LDS_BYTES, stream, a); }
    else for (int p = 0; p < NPH; ++p) { a.ph_lo = p; a.ph_hi = p + 1; hipLaunchKernelGGL(fwd_kernel, dim3(grid), dim3(NTHR), LDS_BYTES, stream, a); }
}
```

```cpp
#include <hip/hip_runtime.h>
#include <cstdio>
#include <cstdint>

#define GAS __attribute__((address_space(1)))
#define LAS __attribute__((address_space(3)))
#define DI __device__ __forceinline__
typedef unsigned short bf16;
typedef short bf16x8 __attribute__((ext_vector_type(8)));
typedef short bf16x4 __attribute__((ext_vector_type(4)));
typedef float f32x4 __attribute__((ext_vector_type(4)));
typedef float f32x2 __attribute__((ext_vector_type(2)));
typedef unsigned u32x4 __attribute__((ext_vector_type(4)));
typedef unsigned u32x2 __attribute__((ext_vector_type(2)));

constexpr int NB = 8, SEQ = 2048, D = 1024, T = NB * SEQ;
constexpr int AH = 8, NCH = SEQ / 64;
constexpr int NE = 32, LISTCAP = 16384;
constexpr int MODW = 14336;
constexpr int NWAVES = 8, NTHR = 512;
constexpr float EPS = 1e-6f;

constexpr size_t MiB = 1u << 20;
constexpr size_t WS_CTL = 0, CTL_ZERO_BYTES = 1 * MiB;
constexpr size_t WS_MOD = 1 * MiB, WS_ROPE = 2 * MiB, WS_AB = 3 * MiB, WS_RGATE = 4 * MiB, WS_LIST = 5 * MiB, WS_GTOT = 7 * MiB;
constexpr size_t WS_WIN_T = 8 * MiB, WS_WOUT_T = 16 * MiB, WS_KV_T = 18 * MiB, WS_WQ_T = 19 * MiB, WS_BWOUT_T = 21 * MiB;
constexpr size_t WS_UP_T = 32 * MiB, WS_DOWN_T = 288 * MiB;
constexpr size_t WS_H = 416 * MiB, WS_HQ = 448 * MiB, WS_HKV = 480 * MiB, WS_PROJ = 512 * MiB;
constexpr size_t WS_UT = 640 * MiB, WS_WNEG = 704 * MiB, WS_QD = 736 * MiB, WS_KTT = 768 * MiB, WS_QK = 800 * MiB;
constexpr size_t WS_O = 816 * MiB, WS_ON = 848 * MiB, WS_X1 = 880 * MiB, WS_X2 = 944 * MiB;
constexpr size_t WS_ACT = 1008 * MiB, WS_YS = 1152 * MiB, WS_QKV = 1280 * MiB, WS_QN = 1320 * MiB, WS_KN = 1352 * MiB, WS_VT = 1356 * MiB;
constexpr size_t WS_END = 1360 * MiB;
constexpr int CW_CNT = 1024;
constexpr int CW_BAR = 4096;

constexpr int RING_BYTES = 131072;
constexpr int LDS_BYTES = 147456;
constexpr int MISC_OFF = LDS_BYTES - 2048;
constexpr int TAB_OFF = MISC_OFF + 256;

DI unsigned f2bf(float f) { unsigned u = __builtin_bit_cast(unsigned, f); return (u + 0x7fffu + ((u >> 16) & 1u)) >> 16; }
DI unsigned pk2(float lo, float hi) { return f2bf(lo) | (f2bf(hi) << 16); }
DI float bf2f(unsigned b) { return __builtin_bit_cast(float, b << 16); }
DI float bflo(unsigned w) { return __builtin_bit_cast(float, w << 16); }
DI float bfhi(unsigned w) { return __builtin_bit_cast(float, w & 0xffff0000u); }
DI float wave_sum(float v) {
#pragma unroll
    for (int o = 1; o < 64; o <<= 1) v += __shfl_xor(v, o);
    return v;
}
DI float sigmoidf_(float x) { return 1.f / (1.f + __expf(-x)); }
DI float siluf_(float x) { return x / (1.f + __expf(-x)); }
#define LDS_WAIT() asm volatile("s_waitcnt lgkmcnt(0)" ::: "memory")
#define VM_WAIT() asm volatile("s_waitcnt vmcnt(0)" ::: "memory")
#define MFMA16(a, b, c) __builtin_amdgcn_mfma_f32_16x16x32_bf16((a), (b), (c), 0, 0, 0)

#define XB_TMO      128
#define XB_XCNT(j)  (256  + 64 * (j))
#define XB_XSUB(j)  (1280 + 64 * (j))
#define XB_XGEN(j)  (2304 + 64 * (j))
#define XB_TOP      3328
#define XB_TOPGEN   3392
#define XCD_BAR_WORDS 3456
#define XB_SPIN_CAP (1u << 18)
__device__ __forceinline__ unsigned xb_ld(unsigned* p)              { return __hip_atomic_load(p, __ATOMIC_RELAXED, __HIP_MEMORY_SCOPE_AGENT); }
__device__ __forceinline__ unsigned xb_add(unsigned* p, unsigned v) { return __hip_atomic_fetch_add(p, v, __ATOMIC_RELAXED, __HIP_MEMORY_SCOPE_AGENT); }
__device__ __forceinline__ unsigned xb_xcc_id() { return (unsigned)__builtin_amdgcn_s_getreg((3 << 11) | 20) & 0xFu; }
#define XB_SPIN(cond, bar) do { unsigned _sp = 0; while (cond) { __builtin_amdgcn_s_sleep(1); \
    if ((++_sp & 255u) == 0u) { if (xb_ld(&(bar)[XB_TMO])) break; if (_sp > XB_SPIN_CAP) { atomicAdd(&(bar)[XB_TMO], 1u); break; } } } } while (0)
struct XcdBarrier { unsigned* bar; unsigned x; volatile LAS unsigned* st; };
__device__ __forceinline__ XcdBarrier xcd_barrier_post(unsigned* bar, volatile LAS unsigned* st) {
    XcdBarrier b; b.bar = bar; b.x = xb_xcc_id(); b.st = st;
    if (threadIdx.x == 0) (void)xb_add(&bar[XB_XCNT(b.x)], 1u);
    return b;
}
__device__ __forceinline__ void xcd_barrier_complete(unsigned* bar, unsigned x, unsigned& nloc, unsigned& nx) {
    const unsigned G = gridDim.x * gridDim.y * gridDim.z;
    unsigned sum, cnt, mine, sp = 0u;
    for (;;) {
        sum = 0u; cnt = 0u; mine = 0u;
#pragma unroll
        for (unsigned j = 0; j < 16; ++j) { const unsigned c = xb_ld(&bar[XB_XCNT(j)]); sum += c; cnt += (c > 0u) ? 1u : 0u; mine = (j == x) ? c : mine; }
        if (sum == G) break;
        __builtin_amdgcn_s_sleep(1);
        if ((++sp & 255u) == 0u) { if (xb_ld(&bar[XB_TMO])) break; if (sp > XB_SPIN_CAP) { atomicAdd(&bar[XB_TMO], 1u); break; } }
    }
    nloc = mine > 0u ? mine : 1u; nx = cnt > 0u ? cnt : 1u;
}
__device__ __forceinline__ void xcd_barrier(const XcdBarrier& b) {
    asm volatile("s_waitcnt vmcnt(0)" ::: "memory");
    __syncthreads();
    if (threadIdx.x == 0) {
        unsigned* bar = b.bar;
        __builtin_amdgcn_s_waitcnt(0);
        unsigned nloc = b.st[0], nx = b.st[1];
        if (nloc == 0u) { xcd_barrier_complete(bar, b.x, nloc, nx); b.st[0] = nloc; b.st[1] = nx; }
        const unsigned old = xb_add(&bar[XB_XSUB(b.x)], 1u);
        const unsigned gen = old / nloc;
        if (old + 1u == (gen + 1u) * nloc) {
            __builtin_amdgcn_fence(__ATOMIC_RELEASE, "agent");
            asm volatile("s_waitcnt vmcnt(0)" ::: "memory");
            const unsigned og = xb_add(&bar[XB_TOP], 1u);
            const unsigned tg = og / nx;
            if (og + 1u == (tg + 1u) * nx) xb_add(&bar[XB_TOPGEN], 1u);
            else XB_SPIN(xb_ld(&bar[XB_TOPGEN]) == tg, bar);
            __builtin_amdgcn_fence(__ATOMIC_ACQUIRE, "agent");
            xb_add(&bar[XB_XGEN(b.x)], 1u);
            asm volatile("s_waitcnt vmcnt(0)" ::: "memory");
        } else {
            XB_SPIN(xb_ld(&bar[XB_XGEN(b.x)]) == gen, bar);
            __builtin_amdgcn_fence(__ATOMIC_ACQUIRE, "agent");
            asm volatile("s_waitcnt vmcnt(0)" ::: "memory");
        }
    }
    __syncthreads();
}

namespace pg8 {
constexpr int BM = 256, BK = 64, HALF = 128, HTB = HALF * BK * 2, KD = 1024;
__host__ __device__ __forceinline__ int lds_byte(int r, int c) { const int st = (r >> 4) * 2 + (c >> 5), rr = r & 15, cc = c & 31, ob = rr * 64 + cc * 2; return st * 1024 + (ob ^ (((ob >> 9) & 1) << 5)); }
__host__ __device__ __forceinline__ void stage_rc(int b, int& R, int& C) { const int st = b / 1024, sb = b % 1024, swz = sb ^ (((sb >> 9) & 1) << 5); R = (st >> 1) * 16 + swz / 64; C = (st & 1) * 32 + (swz % 64) / 2; }
__host__ __device__ __forceinline__ int perm32(int rho) { const int n = rho >> 4, i = rho & 15; return 8 * (i >> 2) + 4 * n + (i & 3); }
struct Unit { int pm, pn, e, rows, mt; };
__device__ __forceinline__ unsigned cvt_pk_bf16(float lo, float hi) { unsigned r; asm volatile("v_cvt_pk_bf16_f32 %0, %1, %2" : "=v"(r) : "v"(lo), "v"(hi)); return r; }

template <class Epi, class Sched>
__device__ __forceinline__ void gemm_phase(LAS unsigned char* lds, const Sched& S, const Epi& E) {
    const int tid = threadIdx.x, wid = __builtin_amdgcn_readfirstlane(tid >> 6), lane = tid & 63, wr = wid >> 2, wc = wid & 3, fr = lane & 15, fq = lane >> 4;
    constexpr int K = KD, nt = K / BK;
    int Rr[2], Cc[2]; unsigned voffB[2];
#pragma unroll
    for (int i = 0; i < 2; ++i) { stage_rc(tid * 16 + i * 8192, Rr[i], Cc[i]); const int Rb = Epi::PERM ? ((Rr[i] & ~31) + perm32(Rr[i] & 31)) : Rr[i]; voffB[i] = (unsigned)(Rb * K + Cc[i]) * 2u; }
    const size_t kstep = (size_t)(BK * 2);
    const size_t hstep = (size_t)HALF * K * 2;
    const unsigned ldsw = (unsigned)wid * 1024u;
    const int aoff = lds_byte(wr * 64 + fr, fq * 8), boff = lds_byte(wc * 32 + fr, fq * 8);
#define PG8_SA(b, h) (((b) * 2 + (h)) * HTB)
#define PG8_SB(b, h) ((4 + (b) * 2 + (h)) * HTB)
#define PG8_STAGE(bufoff, gbase, voff) do { _Pragma("unroll") for (int _i = 0; _i < 2; ++_i) \
        __builtin_amdgcn_global_load_lds((const unsigned*)((const char*)(gbase) + (voff)[_i]), (LAS unsigned*)(lds + (bufoff) + ldsw + _i * 8192), 16, 0, 0); } while (0)
#define PG8_LDA(dst, b, h) do { _Pragma("unroll") for (int m = 0; m < 4; ++m) _Pragma("unroll") for (int k = 0; k < 2; ++k) dst[m][k] = *(const LAS bf16x8*)(lds + PG8_SA(b, h) + aoff + m * 2048 + k * 1024); } while (0)
#define PG8_LDB(dst, b, h) do { _Pragma("unroll") for (int n = 0; n < 2; ++n) _Pragma("unroll") for (int k = 0; k < 2; ++k) dst[n][k] = *(const LAS bf16x8*)(lds + PG8_SB(b, h) + boff + n * 2048 + k * 1024); } while (0)
#define PG8_MMA(ai, bj, At, Bt) do { __builtin_amdgcn_s_setprio(1); _Pragma("unroll") for (int m = 0; m < 4; ++m) _Pragma("unroll") for (int n = 0; n < 2; ++n) _Pragma("unroll") for (int k = 0; k < 2; ++k) \
        acc[ai][bj][m][n] = __builtin_amdgcn_mfma_f32_16x16x32_bf16(Bt[n][k], At[m][k], acc[ai][bj][m][n], 0, 0, 0); __builtin_amdgcn_s_setprio(0); } while (0)
#define PG8_WAIT_V(n) asm volatile("s_waitcnt vmcnt(" #n ")" ::: "memory")
#define PG8_WAIT_L(n) asm volatile("s_waitcnt lgkmcnt(" #n ")" ::: "memory")
#define PG8_BAR __builtin_amdgcn_s_barrier()
#define PG8_SCHED __builtin_amdgcn_sched_barrier(0)
    Unit cur, nxt; int ui = 0;
    if (!S.next(0, cur)) return;
    f32x4 acc[2][2][4][2];
#pragma unroll
    for (int a = 0; a < 2; ++a)
#pragma unroll
        for (int b = 0; b < 2; ++b)
#pragma unroll
            for (int m = 0; m < 4; ++m)
#pragma unroll
                for (int n = 0; n < 2; ++n) acc[a][b][m][n] = (f32x4){0.f, 0.f, 0.f, 0.f};
    bf16x8 At[4][2], B0[2][2], B1[2][2];
    unsigned va[2][2], nva[2][2];
#pragma unroll
    for (int h = 0; h < 2; ++h)
#pragma unroll
        for (int i = 0; i < 2; ++i) va[h][i] = S.a_off(cur, h * HALF + Rr[i], Cc[i]);
    const char* cA = S.a_base(cur); const char* cB = S.b_base(cur);
    PG8_STAGE(PG8_SB(0, 0), cB, voffB); PG8_STAGE(PG8_SA(0, 0), cA, va[0]); PG8_STAGE(PG8_SB(0, 1), cB + hstep, voffB); PG8_STAGE(PG8_SA(0, 1), cA, va[1]);
    if (wr == 1) PG8_BAR;
    PG8_WAIT_V(4); PG8_BAR;
    PG8_STAGE(PG8_SB(1, 0), cB + kstep, voffB); PG8_STAGE(PG8_SA(1, 0), cA + kstep, va[0]); PG8_STAGE(PG8_SB(1, 1), cB + hstep + kstep, voffB);
    PG8_WAIT_V(6); PG8_BAR;
    for (;;) {
        const bool has_next = S.next(ui + 1, nxt);
        const char* nA = cA; const char* nB = cB;
#pragma unroll
        for (int h = 0; h < 2; ++h)
#pragma unroll
            for (int i = 0; i < 2; ++i) nva[h][i] = va[h][i];
        if (has_next) {
            nA = S.a_base(nxt); nB = S.b_base(nxt);
#pragma unroll
            for (int h = 0; h < 2; ++h)
#pragma unroll
                for (int i = 0; i < 2; ++i) nva[h][i] = S.a_off(nxt, h * HALF + Rr[i], Cc[i]);
        }
        asm volatile("" : "+v"(nva[0][0]), "+v"(nva[0][1]), "+v"(nva[1][0]), "+v"(nva[1][1]));
        for (int t = 0; t < nt; t += 2) {
            const bool last = (t == nt - 2);
            const char* a1 = cA + (size_t)(t + 1) * kstep;
            const char* a2 = last ? nA : cA + (size_t)(t + 2) * kstep; const char* b2 = last ? nB : cB + (size_t)(t + 2) * kstep;
            const char* a3 = a2 + kstep; const char* b3 = b2 + kstep;
            unsigned v2[2][2];
#pragma unroll
            for (int h = 0; h < 2; ++h)
#pragma unroll
                for (int i = 0; i < 2; ++i) v2[h][i] = last ? nva[h][i] : va[h][i];
            PG8_LDB(B0, 0, 0); PG8_SCHED; PG8_LDA(At, 0, 0); PG8_STAGE(PG8_SA(1, 1), a1, va[1]);
            PG8_WAIT_L(8); PG8_BAR; PG8_WAIT_L(0); PG8_MMA(0, 0, At, B0); PG8_BAR; PG8_SCHED;
            PG8_LDB(B1, 0, 1); PG8_STAGE(PG8_SB(0, 0), b2, voffB);
            PG8_BAR; PG8_WAIT_L(0); PG8_MMA(0, 1, At, B1); PG8_BAR;
            PG8_LDA(At, 0, 1); PG8_STAGE(PG8_SA(0, 0), a2, v2[0]);
            PG8_BAR; PG8_WAIT_L(0); PG8_MMA(1, 0, At, B0); PG8_BAR; PG8_SCHED;
            PG8_STAGE(PG8_SB(0, 1), b2 + hstep, voffB);
            PG8_WAIT_V(6); PG8_BAR; PG8_MMA(1, 1, At, B1); PG8_BAR;
            PG8_LDB(B0, 1, 0); PG8_SCHED; PG8_LDA(At, 1, 0); PG8_STAGE(PG8_SA(0, 1), a2, v2[1]);
            PG8_WAIT_L(8); PG8_BAR; PG8_WAIT_L(0); PG8_MMA(0, 0, At, B0); PG8_BAR; PG8_SCHED;
            PG8_LDB(B1, 1, 1); PG8_STAGE(PG8_SB(1, 0), b3, voffB);
            PG8_BAR; PG8_WAIT_L(0); PG8_MMA(0, 1, At, B1); PG8_BAR;
            PG8_LDA(At, 1, 1); PG8_STAGE(PG8_SA(1, 0), a3, v2[0]);
            PG8_BAR; PG8_WAIT_L(0); PG8_MMA(1, 0, At, B0); PG8_BAR; PG8_SCHED;
            PG8_STAGE(PG8_SB(1, 1), b3 + hstep, voffB);
            PG8_WAIT_V(6); PG8_BAR; PG8_MMA(1, 1, At, B1); PG8_BAR;
        }
        E(acc, cur, wr, wc, fr, fq);
        if (!has_next) break;
#pragma unroll
        for (int a = 0; a < 2; ++a)
#pragma unroll
            for (int b = 0; b < 2; ++b)
#pragma unroll
                for (int m = 0; m < 4; ++m)
#pragma unroll
                    for (int n = 0; n < 2; ++n) acc[a][b][m][n] = (f32x4){0.f, 0.f, 0.f, 0.f};
        cur = nxt; cA = nA; cB = nB; ++ui;
#pragma unroll
        for (int h = 0; h < 2; ++h)
#pragma unroll
            for (int i = 0; i < 2; ++i) va[h][i] = nva[h][i];
    }
    PG8_WAIT_V(0);
    if (wr == 0) PG8_BAR;
    PG8_BAR;
#undef PG8_SA
#undef PG8_SB
#undef PG8_STAGE
#undef PG8_LDA
#undef PG8_LDB
#undef PG8_MMA
#undef PG8_WAIT_V
#undef PG8_WAIT_L
#undef PG8_BAR
#undef PG8_SCHED
}

struct PlainSched {
    const bf16* A; const bf16* Bt; int nM, nN, G, c;
    __device__ __forceinline__ bool next(int i, Unit& u) const {
        const int nwg = nM * nN; const long L = (long)i * G + c; if (L >= nwg) return false;
        int wgid = (int)L; { const int q = nwg / 8, r = nwg % 8, xcd = wgid % 8, off = wgid / 8; wgid = (xcd < r ? xcd * (q + 1) : r * (q + 1) + (xcd - r) * q) + off; }
        const int nig = 8 * nN, gid = wgid / nig, fm = gid * 8, gsz = (nM - fm) < 8 ? (nM - fm) : 8;
        u.pm = fm + ((wgid % nig) % gsz); u.pn = (wgid % nig) / gsz; u.e = 0; u.rows = 256; u.mt = 0; return true;
    }
    __device__ __forceinline__ const char* a_base(const Unit& u) const { return (const char*)A + (size_t)u.pm * (256 * KD * 2); }
    __device__ __forceinline__ const char* b_base(const Unit& u) const { return (const char*)Bt + (size_t)u.pn * (256 * KD * 2); }
    __device__ __forceinline__ unsigned a_off(const Unit&, int row, int col) const { return (unsigned)(row * KD + col) * 2u; }
};
struct KvqSched {
    const bf16* Akv; const bf16* Aq; const bf16* Bkv; const bf16* Bq; int G, c;
    __device__ __forceinline__ bool next(int i, Unit& u) const {
        const int L = i * G + c; if (L >= 64 * 5) return false;
        u.pm = L / 5; u.pn = L % 5; u.e = 0; u.rows = 256; u.mt = 0; return true;
    }
    __device__ __forceinline__ const char* a_base(const Unit& u) const { return (const char*)(u.pn == 0 ? Akv : Aq) + (size_t)u.pm * (256 * KD * 2); }
    __device__ __forceinline__ const char* b_base(const Unit& u) const { return u.pn == 0 ? (const char*)Bkv : (const char*)Bq + (size_t)(u.pn - 1) * (256 * KD * 2); }
    __device__ __forceinline__ unsigned a_off(const Unit&, int row, int col) const { return (unsigned)(row * KD + col) * 2u; }
};
template <int NPN, bool GATHER>
struct MoeSched {
    const bf16* A; const bf16* Bt; const int* list; const LAS int* tab; int G, c; size_t bstride;
    __device__ __forceinline__ bool next(int i, Unit& u) const {
        const int ntiles = tab[32 + 32]; const int L = i * G + c; const int tile = L / NPN;
        if (tile >= ntiles) return false;
        const int e = tab[80 + tile]; u.pm = tile; u.pn = L % NPN; u.e = e; u.mt = tile - tab[32 + e];
        const int rem = tab[e] - u.mt * 256; u.rows = rem < 256 ? rem : 256; return true;
    }
    __device__ __forceinline__ const char* a_base(const Unit& u) const { return GATHER ? (const char*)A : (const char*)A + (size_t)u.pm * (256 * KD * 2); }
    __device__ __forceinline__ const char* b_base(const Unit& u) const { return (const char*)(Bt + (size_t)u.e * bstride) + (size_t)u.pn * (256 * KD * 2); }
    __device__ __forceinline__ unsigned a_off(const Unit& u, int row, int col) const {
        if (!GATHER) return (unsigned)(row * KD + col) * 2u;
        const int tok = row < u.rows ? (list[u.e * LISTCAP + u.mt * 256 + row] >> 2) : 0;
        return (unsigned)(tok * KD + col) * 2u;
    }
};

struct EpiBf16 {
    static constexpr bool PERM = true;
    bf16* O; int ldc;
    __device__ __forceinline__ void operator()(const f32x4 (&acc)[2][2][4][2], const Unit& u, int wr, int wc, int fr, int fq) const {
        const int row0 = u.pm * BM + wr * 64 + fr, col0 = u.pn * BM + wc * 32 + 8 * fq;
#pragma unroll
        for (int ai = 0; ai < 2; ++ai)
#pragma unroll
            for (int m = 0; m < 4; ++m) { bf16* rowp = O + (size_t)(row0 + ai * HALF + m * 16) * ldc + col0;
#pragma unroll
                for (int bj = 0; bj < 2; ++bj) { const f32x4 v0 = acc[ai][bj][m][0], v1 = acc[ai][bj][m][1];
                    u32x4 w; w.x = cvt_pk_bf16(v0[0], v0[1]); w.y = cvt_pk_bf16(v0[2], v0[3]); w.z = cvt_pk_bf16(v1[0], v1[1]); w.w = cvt_pk_bf16(v1[2], v1[3]);
                    *(u32x4*)(rowp + bj * HALF) = w; } }
    }
};
struct EpiResid {
    static constexpr bool PERM = false;
    const float* base; float* out; const float* gate;
    __device__ __forceinline__ void operator()(const f32x4 (&acc)[2][2][4][2], const Unit& u, int wr, int wc, int fr, int fq) const {
        const int row0 = u.pm * BM + wr * 64 + fr, col0 = u.pn * BM + wc * 32 + 4 * fq;
        const float* gp = gate + (size_t)(u.pm / 8) * MODW + col0;
        f32x4 gv[2][2];
#pragma unroll
        for (int bj = 0; bj < 2; ++bj)
#pragma unroll
            for (int n = 0; n < 2; ++n) gv[bj][n] = *(const f32x4*)(gp + bj * HALF + n * 16);
#pragma unroll
        for (int ai = 0; ai < 2; ++ai)
#pragma unroll
            for (int m = 0; m < 4; ++m) { const size_t off = (size_t)(row0 + ai * HALF + m * 16) * D + col0;
#pragma unroll
                for (int bj = 0; bj < 2; ++bj)
#pragma unroll
                    for (int n = 0; n < 2; ++n) { const f32x4 bs = *(const f32x4*)(base + off + bj * HALF + n * 16);
                        *(f32x4*)(out + off + bj * HALF + n * 16) = bs + gv[bj][n] * acc[ai][bj][m][n]; }
                asm volatile("" ::: "memory"); }
    }
};
struct EpiSwiglu {
    static constexpr bool PERM = true;
    bf16* act; const float* upb;
    __device__ __forceinline__ void operator()(const f32x4 (&acc)[2][2][4][2], const Unit& u, int wr, int wc, int fr, int fq) const {
        const int row0 = u.pm * BM + wr * 64 + fr, j0 = u.pn * HALF + wc * 32 + 8 * fq;
        const float* bp = upb + (size_t)u.e * 2048 + j0;
        f32x4 bg[2], bl[2];
#pragma unroll
        for (int n = 0; n < 2; ++n) { bg[n] = *(const f32x4*)(bp + 4 * n); bl[n] = *(const f32x4*)(bp + 1024 + 4 * n); }
#pragma unroll
        for (int ai = 0; ai < 2; ++ai)
#pragma unroll
            for (int m = 0; m < 4; ++m) { float o[8];
#pragma unroll
                for (int n = 0; n < 2; ++n) { const f32x4 g = acc[ai][0][m][n] + bg[n], l = acc[ai][1][m][n] + bl[n];
#pragma unroll
                    for (int j = 0; j < 4; ++j) { const float gg = fminf(g[j], 7.0f), ll = fminf(fmaxf(l[j], -7.0f), 7.0f);
                        o[4 * n + j] = gg * (1.f / (1.f + __expf(-1.702f * gg))) * (ll + 1.0f); } }
                u32x4 w; w.x = cvt_pk_bf16(o[0], o[1]); w.y = cvt_pk_bf16(o[2], o[3]); w.z = cvt_pk_bf16(o[4], o[5]); w.w = cvt_pk_bf16(o[6], o[7]);
                *(u32x4*)(act + (size_t)(row0 + ai * HALF + m * 16) * 1024 + j0) = w; }
    }
};
struct EpiDown {
    static constexpr bool PERM = true;
    bf16* ys; const float* dnb; const int* list;
    __device__ __forceinline__ void operator()(const f32x4 (&acc)[2][2][4][2], const Unit& u, int wr, int wc, int fr, int fq) const {
        const int r0 = wr * 64 + fr, col0 = u.pn * BM + wc * 32 + 8 * fq;
        const float* bp = dnb + (size_t)u.e * 1024 + col0;
        f32x4 bv[2][2];
#pragma unroll
        for (int bj = 0; bj < 2; ++bj)
#pragma unroll
            for (int n = 0; n < 2; ++n) bv[bj][n] = *(const f32x4*)(bp + bj * HALF + 4 * n);
        const int* lp = list + u.e * LISTCAP + u.mt * 256;
#pragma unroll
        for (int ai = 0; ai < 2; ++ai)
#pragma unroll
            for (int m = 0; m < 4; ++m) { const int r = r0 + ai * HALF + m * 16;
                if (r < u.rows) { const int slot = lp[r]; bf16* rowp = ys + (size_t)slot * 1024 + col0;
#pragma unroll
                    for (int bj = 0; bj < 2; ++bj) { const f32x4 v0 = acc[ai][bj][m][0] + bv[bj][0], v1 = acc[ai][bj][m][1] + bv[bj][1];
                        u32x4 w; w.x = cvt_pk_bf16(v0[0], v0[1]); w.y = cvt_pk_bf16(v0[2], v0[3]); w.z = cvt_pk_bf16(v1[0], v1[1]); w.w = cvt_pk_bf16(v1[2], v1[3]);
                        *(u32x4*)(rowp + bj * HALF) = w; } } }
    }
};
}

struct Args { const float* in[27]; const int* pos; float* out; unsigned char* ws; int ph_lo, ph_hi; };

struct Ctx {
    LAS unsigned char* lds; int tid, lane, wave, vcu, G, gw, NGW;
    unsigned char* ws;
};

DI void tr_item(const float* W, int ldw, int k0, int n0, bf16* WT, int dst_row0, LAS float* scr, int lane) {
    float ld[32];
#pragma unroll
    for (int i = 0; i < 32; ++i) ld[i] = __builtin_nontemporal_load(W + (size_t)(k0 + 2 * i + (lane >> 5)) * ldw + n0 + (lane & 31));
#pragma unroll
    for (int i = 0; i < 32; ++i) scr[(2 * i + (lane >> 5)) * 33 + (lane & 31)] = ld[i];
    LDS_WAIT(); asm volatile("" ::: "memory");
    const int c = lane & 7;
#pragma unroll
    for (int j = 0; j < 4; ++j) { const int n = (lane >> 3) + 8 * j; const LAS float* s = scr + (8 * c) * 33 + n;
        u32x4 o; o.x = pk2(s[0 * 33], s[1 * 33]); o.y = pk2(s[2 * 33], s[3 * 33]); o.z = pk2(s[4 * 33], s[5 * 33]); o.w = pk2(s[6 * 33], s[7 * 33]);
        *(GAS u32x4*)(WT + (size_t)(dst_row0 + n) * 1024 + k0 + 8 * c) = o; }
    LDS_WAIT(); asm volatile("" ::: "memory");
}

DI void p0_prologue(const Ctx& X, const Args& a) {
    {
        LAS float* CA = (LAS float*)X.lds;
        LAS float* RED = (LAS float*)(X.lds + 32768);
        const float* c = a.in[1];
        for (int idx = X.tid; idx < 8192; idx += NTHR) { const int b = idx >> 10, d = idx & 1023; CA[d * 8 + b] = siluf_(c[idx]); }
        __syncthreads();
        float* MOD = (float*)(X.ws + WS_MOD);
        for (int g = X.vcu; g < 224; g += X.G) {
            const float* W; const float* bias; int ld, outcol;
            if (g < 96) { W = a.in[3] + 64 * g; ld = 6144; bias = a.in[4] + 64 * g; outcol = 64 * g; }
            else if (g < 192) { W = a.in[3] + (size_t)1024 * 6144 + 64 * (g - 96); ld = 6144; bias = a.in[4] + 6144 + 64 * (g - 96); outcol = 6144 + 64 * (g - 96); }
            else { W = a.in[12] + 64 * (g - 192); ld = 2048; bias = a.in[13] + 64 * (g - 192); outcol = 12288 + 64 * (g - 192); }
            float acc[8];
#pragma unroll
            for (int b = 0; b < 8; ++b) acc[b] = 0.f;
            const int d0 = X.wave * 128;
#pragma unroll 8
            for (int dd = 0; dd < 128; ++dd) { const int d = d0 + dd; const float wv = W[(size_t)d * ld + X.lane];
                const f32x4 c0 = *(const LAS f32x4*)(CA + d * 8), c1 = *(const LAS f32x4*)(CA + d * 8 + 4);
                acc[0] += c0[0] * wv; acc[1] += c0[1] * wv; acc[2] += c0[2] * wv; acc[3] += c0[3] * wv;
                acc[4] += c1[0] * wv; acc[5] += c1[1] * wv; acc[6] += c1[2] * wv; acc[7] += c1[3] * wv; }
#pragma unroll
            for (int b = 0; b < 8; ++b) RED[(X.wave * 8 + b) * 64 + X.lane] = acc[b];
            __syncthreads();
            { const int b = X.tid >> 6, col = X.tid & 63; float s = bias[col];
#pragma unroll
              for (int w = 0; w < 8; ++w) s += RED[(w * 8 + b) * 64 + col];
              MOD[(size_t)b * MODW + outcol + col] = s; }
            __syncthreads();
        }
    }
    {
        float* ROPE = (float*)(X.ws + WS_ROPE);
        for (int idx = X.gw * 64 + X.lane; idx < T * 8; idx += X.NGW * 64) {
            const int t = idx >> 3, i = idx & 7;
            const float invf = i == 0 ? 1.0f : i == 1 ? 0.19392274f : i == 2 ? 0.03760603f : i == 3 ? 0.0072926646f : i == 4 ? 0.0014142136f : i == 5 ? 0.0002742482f : i == 6 ? 5.3182957e-05f : 1.0313385e-05f;
            const float ang = (float)a.pos[t] * invf;
            double rev = (double)ang * 0.15915494309189533577; rev -= __builtin_rint(rev);
            const float fr = (float)rev;
            ROPE[t * 16 + i] = __builtin_amdgcn_cosf(fr); ROPE[t * 16 + 8 + i] = __builtin_amdgcn_sinf(fr);
        }
    }
    {
        LAS float* scr = (LAS float*)(X.lds + 65536 + X.wave * 8448);
        bf16* WIN_T = (bf16*)(X.ws + WS_WIN_T); bf16* WOUT_T = (bf16*)(X.ws + WS_WOUT_T); bf16* KV_T = (bf16*)(X.ws + WS_KV_T);
        bf16* WQ_T = (bf16*)(X.ws + WS_WQ_T); bf16* BWOUT_T = (bf16*)(X.ws + WS_BWOUT_T); bf16* UP_T = (bf16*)(X.ws + WS_UP_T); bf16* DOWN_T = (bf16*)(X.ws + WS_DOWN_T);
        constexpr int I0 = 16 * 128, I1 = 512, I2 = 16 * 8, I3 = 512, I4 = 512, I5 = 64 * 1024, I6 = 64 * 512;
        constexpr int NITEMS = I0 + I1 + I2 + I3 + I4 + I5 + I6;
        for (int it = X.gw; it < NITEMS; it += X.NGW) {
            int r = it;
            if (r < I0) { tr_item(a.in[6], 4112, 64 * (r / 128), 32 * (r % 128), WIN_T, 32 * (r % 128), scr, X.lane); continue; } r -= I0;
            if (r < I1) { tr_item(a.in[11], 1024, 64 * (r / 32), 32 * (r % 32), WOUT_T, 32 * (r % 32), scr, X.lane); continue; } r -= I1;
            if (r < I2) { tr_item(a.in[15], 256, 64 * (r / 8), 32 * (r % 8), KV_T, 32 * (r % 8), scr, X.lane); continue; } r -= I2;
            if (r < I3) { tr_item(a.in[17], 1024, 64 * (r / 32), 32 * (r % 32), WQ_T, 32 * (r % 32), scr, X.lane); continue; } r -= I3;
            if (r < I4) { tr_item(a.in[20], 1024, 64 * (r / 32), 32 * (r % 32), BWOUT_T, 32 * (r % 32), scr, X.lane); continue; } r -= I4;
            if (r < I5) { const int mi = r >> 10, rr = r & 1023, kb = rr >> 6, nb = rr & 63, n0 = 32 * nb, half = n0 >> 10, j0 = n0 & 1023;
                tr_item(a.in[23] + (size_t)mi * 1024 * 2048, 2048, 64 * kb, n0, UP_T + (size_t)mi * 2048 * 1024, (j0 >> 7) * 256 + half * 128 + (j0 & 127), scr, X.lane); continue; } r -= I5;
            { const int mi = r >> 9, rr = r & 511, kb = rr >> 5, nb = rr & 31;
                tr_item(a.in[25] + (size_t)mi * 1024 * 1024, 1024, 64 * kb, 32 * nb, DOWN_T + (size_t)mi * 1024 * 1024, 32 * nb, scr, X.lane); }
        }
    }
}

DI void load_affine(const float* gain, const float* scale, const float* shift, int lane, f32x4 (&A)[4], f32x4 (&Bv)[4]) {
#pragma unroll
    for (int j = 0; j < 4; ++j) { const int d = 4 * lane + 256 * j; const f32x4 g = *(const f32x4*)(gain + d), sc = *(const f32x4*)(scale + d); A[j] = g * (sc + 1.0f); Bv[j] = *(const f32x4*)(shift + d); }
}
DI void store_bf16_row(bf16* row, int lane, const f32x4 (&h)[4]) {
#pragma unroll
    for (int j = 0; j < 4; ++j) { u32x2 w; w.x = pk2(h[j][0], h[j][1]); w.y = pk2(h[j][2], h[j][3]); *(u32x2*)(row + 4 * lane + 256 * j) = w; }
}
DI float row_rs(const f32x4 (&v)[4]) {
    float ss = 0.f;
#pragma unroll
    for (int j = 0; j < 4; ++j) ss += (v[j][0] * v[j][0] + v[j][1] * v[j][1]) + (v[j][2] * v[j][2] + v[j][3] * v[j][3]);
    return rsqrtf(wave_sum(ss) * (1.0f / 1024.0f) + EPS);
}

template <int NCH8>
DI void skinny4(const f32x4 (&hv)[4][4], const LAS float* WTL, int lane, float (&res)[NCH8]) {
#pragma unroll
    for (int q = 0; q < NCH8; ++q) res[q] = 0.f;
#pragma unroll 1
    for (int oc = 0; oc < NCH8; ++oc) {
        float p[32];
#pragma unroll
        for (int o = 0; o < 8; ++o) { f32x4 w[4];
#pragma unroll
            for (int j = 0; j < 4; ++j) w[j] = *(const LAS f32x4*)(WTL + (oc * 8 + o) * 1024 + 4 * lane + 256 * j);
#pragma unroll
            for (int tt = 0; tt < 4; ++tt) { float s = 0.f;
#pragma unroll
                for (int j = 0; j < 4; ++j) s += (hv[tt][j][0] * w[j][0] + hv[tt][j][1] * w[j][1]) + (hv[tt][j][2] * w[j][2] + hv[tt][j][3] * w[j][3]);
                p[tt * 8 + o] = s; }
            }
        { const bool hi = (lane & 32) != 0;
#pragma unroll
          for (int i = 0; i < 16; ++i) { const float keep = hi ? p[16 + i] : p[i], send = hi ? p[i] : p[16 + i]; p[i] = keep + __shfl_xor(send, 32); } }
        { const bool hi = (lane & 16) != 0;
#pragma unroll
          for (int i = 0; i < 8; ++i) { const float keep = hi ? p[8 + i] : p[i], send = hi ? p[i] : p[8 + i]; p[i] = keep + __shfl_xor(send, 16); } }
        { const bool hi = (lane & 8) != 0;
#pragma unroll
          for (int i = 0; i < 4; ++i) { const float keep = hi ? p[4 + i] : p[i], send = hi ? p[i] : p[4 + i]; p[i] = keep + __shfl_xor(send, 8); } }
        { const bool hi = (lane & 4) != 0;
#pragma unroll
          for (int i = 0; i < 2; ++i) { const float keep = hi ? p[2 + i] : p[i], send = hi ? p[i] : p[2 + i]; p[i] = keep + __shfl_xor(send, 4); } }
        { const bool hi = (lane & 2) != 0; const float keep = hi ? p[1] : p[0], send = hi ? p[0] : p[1]; p[0] = keep + __shfl_xor(send, 2); }
        const float rsum = p[0] + __shfl_xor(p[0], 1);
#pragma unroll
        for (int q = 0; q < NCH8; ++q) res[q] = (q == oc) ? rsum : res[q];
    }
}

DI void p1_norm1(const Ctx& X, const Args& a) {
    LAS float* WTL = (LAS float*)X.lds;
    const float* w_in = a.in[6];
    for (int idx = X.tid; idx < 16384; idx += NTHR) { const int d = idx >> 4, o = idx & 15; WTL[o * 1024 + d] = w_in[(size_t)d * 4112 + 4096 + o]; }
    __syncthreads();
    const float* MOD = (const float*)(X.ws + WS_MOD); bf16* H = (bf16*)(X.ws + WS_H); float* AB = (float*)(X.ws + WS_AB);
    for (int tb = X.gw; tb < T / 4; tb += X.NGW) {
        const int t0 = tb * 4, b = t0 / SEQ;
        f32x4 A[4], Bv[4]; load_affine(a.in[5], MOD + (size_t)b * MODW + 1024, MOD + (size_t)b * MODW, X.lane, A, Bv);
        f32x4 hv[4][4];
#pragma unroll
        for (int tt = 0; tt < 4; ++tt) { const float* xr = a.in[0] + (size_t)(t0 + tt) * D;
#pragma unroll
            for (int j = 0; j < 4; ++j) hv[tt][j] = *(const f32x4*)(xr + 4 * X.lane + 256 * j); }
#pragma unroll
        for (int tt = 0; tt < 4; ++tt) { const float r = row_rs(hv[tt]);
#pragma unroll
            for (int j = 0; j < 4; ++j) hv[tt][j] = hv[tt][j] * r * A[j] + Bv[j];
            store_bf16_row(H + (size_t)(t0 + tt) * D, X.lane, hv[tt]); }
        float res[2]; skinny4<2>(hv, WTL, X.lane, res);
        if ((X.lane & 1) == 0) { float* ab = AB + (size_t)(t0 + (X.lane >> 4)) * 16 + ((X.lane >> 1) & 7); ab[0] = res[0]; ab[8] = res[1]; }
    }
}

DI void p_norm_router(const Ctx& X, const Args& a, int layer, const float* xin) {
    LAS float* WTL = (LAS float*)X.lds;
    LAS int* HIST = (LAS int*)(X.lds + TAB_OFF); LAS int* BASE = HIST + 32; LAS int* ASG = HIST + 64;
    const float* rw = a.in[21] + (size_t)layer * 1024 * 32; const float* rb = a.in[22] + layer * 32;
    for (int idx = X.tid; idx < 32768; idx += NTHR) { const int d = idx >> 5, o = idx & 31; WTL[o * 1024 + d] = rw[idx]; }
    const float* MOD = (const float*)(X.ws + WS_MOD) + layer * 6144; bf16* H = (bf16*)(X.ws + WS_H);
    float* RGATE = (float*)(X.ws + WS_RGATE); int* LIST = (int*)(X.ws + WS_LIST);
    unsigned* gcnt = (unsigned*)(X.ws + WS_CTL) + CW_CNT + 64 * layer;
    const float* gain = a.in[5] + (size_t)(layer * 2 + 1) * D;
    for (int tb = X.vcu; tb < T / 64; tb += X.G) {
        if (X.tid < 32) HIST[X.tid] = 0;
        __syncthreads();
        const int tw0 = tb * 64 + X.wave * 8, b = tw0 / SEQ;
        int ln0 = X.lane; asm volatile("" : "+v"(ln0));
#pragma unroll 1
        for (int grp = 0; grp < 2; ++grp) {
            int ln = ln0; asm volatile("" : "+v"(ln));
            const int myo = (ln >> 1) & 7;
            const int t0 = tw0 + grp * 4;
            f32x4 A[4], Bv[4]; load_affine(gain, MOD + (size_t)b * MODW + 4096, MOD + (size_t)b * MODW + 3072, ln, A, Bv);
            f32x4 hv[4][4];
#pragma unroll
            for (int tt = 0; tt < 4; ++tt) { const float* xr = xin + (size_t)(t0 + tt) * D;
#pragma unroll
                for (int j = 0; j < 4; ++j) hv[tt][j] = *(const f32x4*)(xr + 4 * ln + 256 * j); }
#pragma unroll
            for (int tt = 0; tt < 4; ++tt) { const float r = row_rs(hv[tt]);
#pragma unroll
                for (int j = 0; j < 4; ++j) hv[tt][j] = hv[tt][j] * r * A[j] + Bv[j];
                store_bf16_row(H + (size_t)(t0 + tt) * D, ln, hv[tt]); }
            float lgv[4]; skinny4<4>(hv, WTL, ln, lgv);
#pragma unroll
            for (int oc = 0; oc < 4; ++oc) lgv[oc] += rb[oc * 8 + myo];
            float tv[4]; int ti[4];
#pragma unroll
            for (int k = 0; k < 4; ++k) { float best = lgv[0]; int bi = myo;
#pragma unroll
                for (int oc = 1; oc < 4; ++oc) if (lgv[oc] > best) { best = lgv[oc]; bi = oc * 8 + myo; }
#pragma unroll
                for (int o = 1; o < 16; o <<= 1) { const float ov = __shfl_xor(best, o); const int oi = __shfl_xor(bi, o); if (ov > best || (ov == best && oi < bi)) { best = ov; bi = oi; } }
                tv[k] = best; ti[k] = bi;
#pragma unroll
                for (int oc = 0; oc < 4; ++oc) if (oc * 8 + myo == bi) lgv[oc] = -3.0e38f; }
            const float e1 = __expf(tv[1] - tv[0]), e2 = __expf(tv[2] - tv[0]), e3 = __expf(tv[3] - tv[0]); const float inv = 1.0f / (1.0f + e1 + e2 + e3);
            const int k = ln & 15, tl = grp * 4 + (ln >> 4);
            if (k < 4) { const int e = k == 0 ? ti[0] : k == 1 ? ti[1] : k == 2 ? ti[2] : ti[3];
                const float gt = (k == 0 ? 1.0f : k == 1 ? e1 : k == 2 ? e2 : e3) * inv;
                const int lr = atomicAdd((int*)&HIST[e], 1);
                ASG[(X.wave * 8 + tl) * 4 + k] = (e << 16) | lr; RGATE[(size_t)(tw0 + tl) * 4 + k] = gt; }
        }
        __syncthreads();
        if (X.tid < 32) BASE[X.tid] = (int)__hip_atomic_fetch_add(gcnt + X.tid, (unsigned)HIST[X.tid], __ATOMIC_RELAXED, __HIP_MEMORY_SCOPE_AGENT);
        __syncthreads();
        if (X.tid < 256) { const int av = ASG[X.tid], e = av >> 16, lr = av & 0xffff; LIST[e * LISTCAP + BASE[e] + lr] = tb * 256 + X.tid; }
        __syncthreads();
    }
}

DI void moe_table(const Ctx& X, int layer) {
    LAS int* tab = (LAS int*)(X.lds + TAB_OFF);
    const unsigned* gcnt = (const unsigned*)(X.ws + WS_CTL) + CW_CNT + 64 * layer;
    if (X.tid < 32) tab[X.tid] = (int)__hip_atomic_load(gcnt + X.tid, __ATOMIC_RELAXED, __HIP_MEMORY_SCOPE_AGENT);
    __syncthreads();
    if (X.tid == 0) { int s = 0; for (int e = 0; e < 32; ++e) { tab[32 + e] = s; s += (tab[e] + 255) >> 8; } tab[64] = s; }
    __syncthreads();
    if (X.tid < 32) { const int s0 = tab[32 + X.tid], s1 = tab[33 + X.tid]; for (int q = s0; q < s1; ++q) tab[80 + q] = X.tid; }
    __syncthreads();
}

DI void p10_combine_norm(const Ctx& X, const Args& a) {
    const float* MOD = (const float*)(X.ws + WS_MOD); const float* X1 = (const float*)(X.ws + WS_X1); float* X2 = (float*)(X.ws + WS_X2);
    const bf16* YS = (const bf16*)(X.ws + WS_YS); const float* RGATE = (const float*)(X.ws + WS_RGATE);
    bf16* HKV = (bf16*)(X.ws + WS_HKV); bf16* HQ = (bf16*)(X.ws + WS_HQ);
    for (int tb = X.gw; tb < T / 8; tb += X.NGW) {
        const int t0 = tb * 8, b = t0 / SEQ; const float* mb = MOD + (size_t)b * MODW;
        f32x4 G2[4], Ak[4], Bk[4], Aq[4], Bq[4];
#pragma unroll
        for (int j = 0; j < 4; ++j) G2[j] = *(const f32x4*)(mb + 5120 + 4 * X.lane + 256 * j);
        load_affine(a.in[14], mb + 12288 + 1024, mb + 12288, X.lane, Ak, Bk);
        load_affine(a.in[5] + 2 * D, mb + 6144 + 1024, mb + 6144, X.lane, Aq, Bq);
        for (int tt = 0; tt < 8; ++tt) {
            const int t = t0 + tt;
            const f32x4 gt = *(const f32x4*)(RGATE + (size_t)t * 4);
            f32x4 v[4];
#pragma unroll
            for (int j = 0; j < 4; ++j) { const int d = 4 * X.lane + 256 * j; f32x4 s = (f32x4){0.f, 0.f, 0.f, 0.f};
#pragma unroll
                for (int k = 0; k < 4; ++k) { const u32x2 w = *(const u32x2*)(YS + ((size_t)t * 4 + k) * 1024 + d); const float g = gt[k];
                    s[0] += g * bflo(w.x); s[1] += g * bfhi(w.x); s[2] += g * bflo(w.y); s[3] += g * bfhi(w.y); }
                v[j] = *(const f32x4*)(X1 + (size_t)t * D + d) + G2[j] * s; *(f32x4*)(X2 + (size_t)t * D + d) = v[j]; }
            const float r = row_rs(v);
            f32x4 h[4];
#pragma unroll
            for (int j = 0; j < 4; ++j) h[j] = v[j] * r * Ak[j] + Bk[j];
            store_bf16_row(HKV + (size_t)t * D, X.lane, h);
#pragma unroll
            for (int j = 0; j < 4; ++j) h[j] = v[j] * r * Aq[j] + Bq[j];
            store_bf16_row(HQ + (size_t)t * D, X.lane, h);
        }
    }
}
DI void p18_final(const Ctx& X, const Args& a) {
    const float* MOD = (const float*)(X.ws + WS_MOD); const float* X3 = (const float*)(X.ws + WS_X1);
    const bf16* YS = (const bf16*)(X.ws + WS_YS); const float* RGATE = (const float*)(X.ws + WS_RGATE);
    for (int tb = X.gw; tb < T / 8; tb += X.NGW) {
        const int t0 = tb * 8, b = t0 / SEQ; const float* mb = MOD + (size_t)b * MODW + 6144;
        f32x4 G2[4];
#pragma unroll
        for (int j = 0; j < 4; ++j) G2[j] = *(const f32x4*)(mb + 5120 + 4 * X.lane + 256 * j);
        for (int tt = 0; tt < 8; ++tt) {
            const int t = t0 + tt;
            const f32x4 gt = *(const f32x4*)(RGATE + (size_t)t * 4);
#pragma unroll
            for (int j = 0; j < 4; ++j) { const int d = 4 * X.lane + 256 * j; f32x4 s = (f32x4){0.f, 0.f, 0.f, 0.f};
#pragma unroll
                for (int k = 0; k < 4; ++k) { const u32x2 w = *(const u32x2*)(YS + ((size_t)t * 4 + k) * 1024 + d); const float g = gt[k];
                    s[0] += g * bflo(w.x); s[1] += g * bfhi(w.x); s[2] += g * bflo(w.y); s[3] += g * bfhi(w.y); }
                *(f32x4*)(a.out + (size_t)t * D + d) = *(const f32x4*)(X3 + (size_t)t * D + d) + G2[j] * s; }
        }
    }
}

DI void unpack16(const u32x4 a, const u32x4 b, float (&f)[16]) {
    f[0] = bflo(a.x); f[1] = bfhi(a.x); f[2] = bflo(a.y); f[3] = bfhi(a.y); f[4] = bflo(a.z); f[5] = bfhi(a.z); f[6] = bflo(a.w); f[7] = bfhi(a.w);
    f[8] = bflo(b.x); f[9] = bfhi(b.x); f[10] = bflo(b.y); f[11] = bfhi(b.y); f[12] = bflo(b.z); f[13] = bfhi(b.z); f[14] = bflo(b.w); f[15] = bfhi(b.w);
}
DI void store16(bf16* p, const float (&f)[16]) {
    u32x4 a, b; a.x = pk2(f[0], f[1]); a.y = pk2(f[2], f[3]); a.z = pk2(f[4], f[5]); a.w = pk2(f[6], f[7]); b.x = pk2(f[8], f[9]); b.y = pk2(f[10], f[11]); b.z = pk2(f[12], f[13]); b.w = pk2(f[14], f[15]);
    *(u32x4*)p = a; *(u32x4*)(p + 8) = b;
}
DI void p5_onorm(const Ctx& X, const Args& a) {
    const bf16* O = (const bf16*)(X.ws + WS_O); const bf16* PROJ = (const bf16*)(X.ws + WS_PROJ); bf16* ON = (bf16*)(X.ws + WS_ON);
    float og[16];
#pragma unroll
    for (int i = 0; i < 16; ++i) og[i] = a.in[10][(16 * X.lane + i) & 127];
    for (int t = X.gw; t < T; t += X.NGW) {
        float o[16], z[16];
        unpack16(*(const u32x4*)(O + (size_t)t * D + 16 * X.lane), *(const u32x4*)(O + (size_t)t * D + 16 * X.lane + 8), o);
        unpack16(*(const u32x4*)(PROJ + (size_t)t * 4096 + 3072 + 16 * X.lane), *(const u32x4*)(PROJ + (size_t)t * 4096 + 3072 + 16 * X.lane + 8), z);
        float ss = 0.f;
#pragma unroll
        for (int i = 0; i < 16; ++i) ss += o[i] * o[i];
        ss += __shfl_xor(ss, 1); ss += __shfl_xor(ss, 2); ss += __shfl_xor(ss, 4);
        const float r = rsqrtf(ss * (1.0f / 128.0f) + EPS);
#pragma unroll
        for (int i = 0; i < 16; ++i) o[i] = o[i] * r * og[i] * siluf_(z[i]);
        store16(ON + (size_t)t * D + 16 * X.lane, o);
    }
}

DI void p12_qknorm(const Ctx& X, const Args& a) {
    const bf16* QKV = (const bf16*)(X.ws + WS_QKV); const float* ROPE = (const float*)(X.ws + WS_ROPE);
    bf16* QN = (bf16*)(X.ws + WS_QN); bf16* KN = (bf16*)(X.ws + WS_KN); bf16* VT = (bf16*)(X.ws + WS_VT);
    float qg[16], kg[16];
#pragma unroll
    for (int i = 0; i < 16; ++i) { qg[i] = a.in[18][(16 * X.lane + i) & 63]; kg[i] = a.in[16][(16 * X.lane + i) & 63]; }
    for (int t = X.gw; t < T; t += X.NGW) {
        const int b = t / SEQ, s = t % SEQ;
        float cs[8], sn[8];
        { const f32x4 c0 = *(const f32x4*)(ROPE + (size_t)t * 16), c1 = *(const f32x4*)(ROPE + (size_t)t * 16 + 4), s0 = *(const f32x4*)(ROPE + (size_t)t * 16 + 8), s1 = *(const f32x4*)(ROPE + (size_t)t * 16 + 12);
#pragma unroll
          for (int i = 0; i < 4; ++i) { cs[i] = c0[i]; cs[4 + i] = c1[i]; sn[i] = s0[i]; sn[4 + i] = s1[i]; } }
        float q[16];
        unpack16(*(const u32x4*)(QKV + (size_t)t * 1280 + 256 + 16 * X.lane), *(const u32x4*)(QKV + (size_t)t * 1280 + 256 + 16 * X.lane + 8), q);
        float ss = 0.f;
#pragma unroll
        for (int i = 0; i < 16; ++i) ss += q[i] * q[i];
        ss += __shfl_xor(ss, 1); ss += __shfl_xor(ss, 2);
        float r = rsqrtf(ss * (1.0f / 64.0f) + EPS);
#pragma unroll
        for (int i = 0; i < 16; ++i) q[i] = q[i] * r * qg[i];
        if ((X.lane & 3) == 0) {
#pragma unroll
            for (int i = 0; i < 8; ++i) { const float x1 = q[i], x2 = q[8 + i]; q[i] = x1 * cs[i] - x2 * sn[i]; q[8 + i] = x2 * cs[i] + x1 * sn[i]; } }
#pragma unroll
        for (int i = 0; i < 16; ++i) q[i] *= 0.125f;
        store16(QN + (size_t)t * D + 16 * X.lane, q);
        if (X.lane < 8) {
            float k[16], v[16];
            unpack16(*(const u32x4*)(QKV + (size_t)t * 1280 + 16 * X.lane), *(const u32x4*)(QKV + (size_t)t * 1280 + 16 * X.lane + 8), k);
            unpack16(*(const u32x4*)(QKV + (size_t)t * 1280 + 128 + 16 * X.lane), *(const u32x4*)(QKV + (size_t)t * 1280 + 128 + 16 * X.lane + 8), v);
            float s2 = 0.f;
#pragma unroll
            for (int i = 0; i < 16; ++i) s2 += k[i] * k[i];
            s2 += __shfl_xor(s2, 1); s2 += __shfl_xor(s2, 2);
            r = rsqrtf(s2 * (1.0f / 64.0f) + EPS);
#pragma unroll
            for (int i = 0; i < 16; ++i) k[i] = k[i] * r * kg[i];
            if ((X.lane & 3) == 0) {
#pragma unroll
                for (int i = 0; i < 8; ++i) { const float x1 = k[i], x2 = k[8 + i]; k[i] = x1 * cs[i] - x2 * sn[i]; k[8 + i] = x2 * cs[i] + x1 * sn[i]; } }
            const int kvh = X.lane >> 2, d0 = (16 * X.lane) & 63;
            store16(KN + ((size_t)(b * 2 + kvh) * SEQ + s) * 64 + d0, k);
#pragma unroll
            for (int i = 0; i < 16; ++i) VT[((size_t)(b * 2 + kvh) * 64 + d0 + i) * SEQ + s] = (bf16)f2bf(v[i]);
        }
    }
}

#define MFMA4F(a, b, c) __builtin_amdgcn_mfma_f32_16x16x4f32((a), (b), (c), 0, 0, 0)
constexpr int P3_QB = 0, P3_KB = 17408, P3_RT = 34816, P3_AF = 71680, P3_TF = 89088, P3_WS = 106496, P3_TB = 123904, P3_GC = 133120;
DI f32x4 blk_mm(f32x4 acc, const LAS float* Xm, int xr0, int xc0, const LAS float* Ym, int yr0, int yc0, int fr, int fq) {
#pragma unroll
    for (int s = 0; s < 4; ++s) acc = MFMA4F(Xm[(xr0 + fr) * 68 + xc0 + 4 * s + fq], Ym[(yr0 + 4 * s + fq) * 68 + yc0 + fr], acc);
    return acc;
}
DI void blk_st(LAS float* M, int r0, int c0, const f32x4 acc, float sgn, int fr, int fq) {
#pragma unroll
    for (int r = 0; r < 4; ++r) M[(r0 + 4 * fq + r) * 68 + c0 + fr] = sgn * acc[r];
}
DI void blk_st_tb(LAS float* TF, LAS bf16* TB, int r0, int c0, const f32x4 acc, int fr, int fq) {
#pragma unroll
    for (int r = 0; r < 4; ++r) { TF[(r0 + 4 * fq + r) * 68 + c0 + fr] = -acc[r]; TB[(r0 + 4 * fq + r) * 72 + c0 + fr] = (bf16)f2bf(-acc[r]); }
}
DI u32x4 pack8(const float (&f)[8]) { u32x4 w; w.x = pk2(f[0], f[1]); w.y = pk2(f[2], f[3]); w.z = pk2(f[4], f[5]); w.w = pk2(f[6], f[7]); return w; }
DI void p3_prep(const Ctx& X, const Args& a) {
    LAS bf16* QB = (LAS bf16*)(X.lds + P3_QB); LAS bf16* KBb = (LAS bf16*)(X.lds + P3_KB); LAS bf16* RT = (LAS bf16*)(X.lds + P3_RT);
    LAS float* AF = (LAS float*)(X.lds + P3_AF); LAS float* TF = (LAS float*)(X.lds + P3_TF); LAS float* WSm = (LAS float*)(X.lds + P3_WS);
    LAS bf16* TB = (LAS bf16*)(X.lds + P3_TB);
    LAS float* GC = (LAS float*)(X.lds + P3_GC); LAS float* BETA = GC + 64; LAS float* EG = GC + 128;
    const bf16* PROJ = (const bf16*)(X.ws + WS_PROJ); const float* AB = (const float*)(X.ws + WS_AB);
    float* UT = (float*)(X.ws + WS_UT); bf16* WNEG = (bf16*)(X.ws + WS_WNEG); bf16* QD = (bf16*)(X.ws + WS_QD); bf16* KTT = (bf16*)(X.ws + WS_KTT); bf16* QKG = (bf16*)(X.ws + WS_QK);
    float* GTOT = (float*)(X.ws + WS_GTOT);
    const float* convw = a.in[7];
    const int fr_ = X.lane & 15, fq_ = X.lane >> 4;
    for (int idx = X.tid; idx < 64 * 72 / 2; idx += NTHR) ((LAS unsigned*)TB)[idx] = 0u;
    __syncthreads();
    for (int cid = X.vcu; cid < NB * AH * NCH; cid += X.G) {
        int fr = fr_, fq = fq_; asm volatile("" : "+v"(fr), "+v"(fq));
        const int b = cid >> 8, h = (cid >> 5) & 7, n = cid & 31, t0 = b * SEQ + n * 64;
        const size_t rowbase = (size_t)(b * 8 + h) * SEQ + n * 64;
        const int which = X.wave >> 1, rs = (X.wave & 1) * 4 + fq, cg = fr;
        u32x4 xr[11]; f32x4 cw[4][2];
        if (X.wave < 6) {
            const int ch0 = which * 1024 + h * 128 + 8 * cg;
            const bf16* src = PROJ + ((ptrdiff_t)t0 + 8 * rs - 3) * 4096 + ch0;
#pragma unroll
            for (int m = 0; m < 11; ++m) { const bool valid = (n > 0) || (8 * rs - 3 + m >= 0); xr[m] = (u32x4){0u, 0u, 0u, 0u}; if (valid) xr[m] = *(const u32x4*)(src + (ptrdiff_t)m * 4096); }
#pragma unroll
            for (int i = 0; i < 4; ++i) { cw[i][0] = *(const f32x4*)(convw + i * 3072 + ch0); cw[i][1] = *(const f32x4*)(convw + i * 3072 + ch0 + 4); }
        } else if (X.wave == 6) {
            const int i = fq * 16 + fr;
            const float av = AB[(size_t)(t0 + i) * 16 + h], bv = AB[(size_t)(t0 + i) * 16 + 8 + h];
            const float xx = av + a.in[9][h]; const float sp = xx > 20.f ? xx : log1pf(__expf(xx));
            float g = -__expf(a.in[8][h]) * sp;
#pragma unroll
            for (int o = 1; o < 64; o <<= 1) { const float up = __shfl_up(g, o); if (i >= o) g += up; }
            GC[i] = g; BETA[i] = sigmoidf_(bv); EG[i] = __expf(g);
            if (i == 63) GTOT[cid] = __expf(g);
        }
        __syncthreads();
        if (X.wave < 6) {
            float y[8][8];
#pragma unroll
            for (int ch = 0; ch < 8; ++ch) { float xc[11];
#pragma unroll
                for (int m = 0; m < 11; ++m) { const unsigned wv = xr[m][ch >> 1]; xc[m] = (ch & 1) ? bfhi(wv) : bflo(wv); }
                const float w0 = cw[0][ch >> 2][ch & 3], w1 = cw[1][ch >> 2][ch & 3], w2 = cw[2][ch >> 2][ch & 3], w3 = cw[3][ch >> 2][ch & 3];
#pragma unroll
                for (int rr = 0; rr < 8; ++rr) y[rr][ch] = siluf_(w0 * xc[rr] + w1 * xc[rr + 1] + w2 * xc[rr + 2] + w3 * xc[rr + 3]); }
            float be[8], eg[8], gcr[8];
#pragma unroll
            for (int rr = 0; rr < 8; ++rr) { be[rr] = BETA[8 * rs + rr]; eg[rr] = EG[8 * rs + rr]; gcr[rr] = GC[8 * rs + rr]; }
            if (which < 2) {
#pragma unroll
                for (int rr = 0; rr < 8; ++rr) { float ss = 0.f;
#pragma unroll
                    for (int ch = 0; ch < 8; ++ch) ss += y[rr][ch] * y[rr][ch];
                    ss += __shfl_xor(ss, 1); ss += __shfl_xor(ss, 2); ss += __shfl_xor(ss, 4); ss += __shfl_xor(ss, 8);
                    const float r = rsqrtf(ss + EPS) * (which == 0 ? 0.08838834764831845f : 1.0f);
#pragma unroll
                    for (int ch = 0; ch < 8; ++ch) y[rr][ch] *= r; }
            }
            if (which == 0) {
#pragma unroll
                for (int rr = 0; rr < 8; ++rr) { *(LAS u32x4*)(QB + (8 * rs + rr) * 136 + 8 * cg) = pack8(y[rr]);
                    float s[8];
#pragma unroll
                    for (int ch = 0; ch < 8; ++ch) s[ch] = y[rr][ch] * eg[rr];
                    *(u32x4*)(QD + (rowbase + 8 * rs + rr) * 128 + 8 * cg) = pack8(s); }
            } else if (which == 1) {
                const float gl = GC[63];
                float tail[8];
#pragma unroll
                for (int rr = 0; rr < 8; ++rr) { *(LAS u32x4*)(KBb + (8 * rs + rr) * 136 + 8 * cg) = pack8(y[rr]); tail[rr] = __expf(gl - gcr[rr]); }
#pragma unroll
                for (int ch = 0; ch < 8; ++ch) { float s[8], u[8];
#pragma unroll
                    for (int rr = 0; rr < 8; ++rr) { s[rr] = y[rr][ch] * be[rr] * eg[rr]; u[rr] = y[rr][ch] * tail[rr]; }
                    *(LAS u32x4*)(RT + (128 + 8 * cg + ch) * 72 + 8 * rs) = pack8(s);
                    *(u32x4*)(KTT + (size_t)cid * 8192 + (8 * cg + ch) * 64 + 8 * rs) = pack8(u); }
            } else {
#pragma unroll
                for (int ch = 0; ch < 8; ++ch) { float s[8];
#pragma unroll
                    for (int rr = 0; rr < 8; ++rr) s[rr] = y[rr][ch] * be[rr];
                    *(LAS u32x4*)(RT + (8 * cg + ch) * 72 + 8 * rs) = pack8(s); }
            }
        }
        __syncthreads();
        if (X.wave == 0) {
#pragma unroll
            for (int ab = 0; ab < 10; ++ab) { const int ta = ab < 1 ? 0 : ab < 3 ? 1 : ab < 6 ? 2 : 3, tb = ab - (ta * (ta + 1)) / 2;
                f32x4 acc = (f32x4){0.f, 0.f, 0.f, 0.f};
#pragma unroll
                for (int kk = 0; kk < 4; ++kk) acc = MFMA16(*(const LAS bf16x8*)(KBb + (16 * ta + fr) * 136 + kk * 32 + fq * 8), *(const LAS bf16x8*)(KBb + (16 * tb + fr) * 136 + kk * 32 + fq * 8), acc);
                const int j = 16 * tb + fr; const float gj = GC[j];
#pragma unroll
                for (int r = 0; r < 4; ++r) { const int i = 16 * ta + 4 * fq + r; AF[i * 68 + j] = (i > j) ? acc[r] * BETA[i] * __expf(fminf(GC[i] - gj, 0.f)) : 0.f; } }
            asm volatile("s_waitcnt lgkmcnt(0)" ::: "memory");
            {
                const int kb = fq, c = fr; float t[16];
#pragma unroll
                for (int ii = 0; ii < 16; ++ii) { const LAS float* ar = AF + (16 * kb + ii) * 68 + 16 * kb;
                    float av[16];
#pragma unroll
                    for (int q = 0; q < 4; ++q) { const f32x4 v4 = *(const LAS f32x4*)(ar + 4 * q); av[4 * q] = v4[0]; av[4 * q + 1] = v4[1]; av[4 * q + 2] = v4[2]; av[4 * q + 3] = v4[3]; }
                    float s = (ii == c) ? 1.f : 0.f;
#pragma unroll
                    for (int jj = 0; jj < ii; ++jj) s -= av[jj] * t[jj];
                    t[ii] = s; }
#pragma unroll
                for (int ii = 0; ii < 16; ++ii) { TF[(16 * kb + ii) * 68 + 16 * kb + c] = t[ii]; TB[(16 * kb + ii) * 72 + 16 * kb + c] = (bf16)f2bf(t[ii]); }
            }
            asm volatile("s_waitcnt lgkmcnt(0)" ::: "memory");
            const f32x4 z4 = (f32x4){0.f, 0.f, 0.f, 0.f};
            { const f32x4 w10 = blk_mm(z4, AF, 16, 0, TF, 0, 0, fr, fq), w32 = blk_mm(z4, AF, 48, 32, TF, 32, 32, fr, fq);
              blk_st(WSm, 16, 0, w10, 1.f, fr, fq); blk_st(WSm, 48, 32, w32, 1.f, fr, fq); }
            asm volatile("s_waitcnt lgkmcnt(0)" ::: "memory");
            { const f32x4 t10 = blk_mm(z4, TF, 16, 16, WSm, 16, 0, fr, fq), t32 = blk_mm(z4, TF, 48, 48, WSm, 48, 32, fr, fq);
              blk_st_tb(TF, TB, 16, 0, t10, fr, fq); blk_st_tb(TF, TB, 48, 32, t32, fr, fq); }
            asm volatile("s_waitcnt lgkmcnt(0)" ::: "memory");
            { f32x4 w20 = blk_mm(z4, AF, 32, 0, TF, 0, 0, fr, fq); w20 = blk_mm(w20, AF, 32, 16, TF, 16, 0, fr, fq);
              f32x4 w30 = blk_mm(z4, AF, 48, 0, TF, 0, 0, fr, fq); w30 = blk_mm(w30, AF, 48, 16, TF, 16, 0, fr, fq);
              const f32x4 w21 = blk_mm(z4, AF, 32, 16, TF, 16, 16, fr, fq), w31 = blk_mm(z4, AF, 48, 16, TF, 16, 16, fr, fq);
              blk_st(WSm, 32, 0, w20, 1.f, fr, fq); blk_st(WSm, 48, 0, w30, 1.f, fr, fq); blk_st(WSm, 32, 16, w21, 1.f, fr, fq); blk_st(WSm, 48, 16, w31, 1.f, fr, fq); }
            asm volatile("s_waitcnt lgkmcnt(0)" ::: "memory");
            { const f32x4 t20 = blk_mm(z4, TF, 32, 32, WSm, 32, 0, fr, fq), t21 = blk_mm(z4, TF, 32, 32, WSm, 32, 16, fr, fq);
              f32x4 t30 = blk_mm(z4, TF, 48, 32, WSm, 32, 0, fr, fq); t30 = blk_mm(t30, TF, 48, 48, WSm, 48, 0, fr, fq);
              f32x4 t31 = blk_mm(z4, TF, 48, 32, WSm, 32, 16, fr, fq); t31 = blk_mm(t31, TF, 48, 48, WSm, 48, 16, fr, fq);
              blk_st_tb(TF, TB, 32, 0, t20, fr, fq); blk_st_tb(TF, TB, 32, 16, t21, fr, fq); blk_st_tb(TF, TB, 48, 0, t30, fr, fq); blk_st_tb(TF, TB, 48, 16, t31, fr, fq); }
        } else {
            for (int tt = X.wave - 1; tt < 16; tt += 7) { const int it = tt >> 2, jt = tt & 3;
                f32x4 acc = (f32x4){0.f, 0.f, 0.f, 0.f};
                if (it >= jt) {
#pragma unroll
                    for (int kk = 0; kk < 4; ++kk) acc = MFMA16(*(const LAS bf16x8*)(KBb + (16 * jt + fr) * 136 + kk * 32 + fq * 8), *(const LAS bf16x8*)(QB + (16 * it + fr) * 136 + kk * 32 + fq * 8), acc);
                }
                const int i = 16 * it + fr; const float gi = GC[i]; float v[4];
#pragma unroll
                for (int r = 0; r < 4; ++r) { const int j = 16 * jt + 4 * fq + r; v[r] = (j <= i) ? acc[r] * __expf(fminf(gi - GC[j], 0.f)) : 0.f; }
                u32x2 p; p.x = pk2(v[0], v[1]); p.y = pk2(v[2], v[3]);
                *(u32x2*)(QKG + (size_t)cid * 4096 + i * 64 + 16 * jt + 4 * fq) = p; }
        }
        __syncthreads();
        {
            const int half = X.wave >> 2, it = X.wave & 3, ns = it < 2 ? 1 : 2;
            bf16x8 tf[2];
#pragma unroll
            for (int s = 0; s < 2; ++s) tf[s] = *(const LAS bf16x8*)(TB + (16 * it + fr) * 72 + 32 * (s < ns ? s : 0) + 8 * fq);
#pragma unroll
            for (int ct = 0; ct < 8; ++ct) { const int c0 = half * 128 + 16 * ct;
                f32x4 acc = (f32x4){0.f, 0.f, 0.f, 0.f};
                if (half == 0) {
#pragma unroll
                    for (int s = 0; s < 2; ++s) if (s < ns) acc = MFMA16(tf[s], *(const LAS bf16x8*)(RT + (c0 + fr) * 72 + 32 * s + 8 * fq), acc);
                    *(f32x4*)(UT + (size_t)cid * 8192 + (c0 + fr) * 64 + 16 * it + 4 * fq) = acc;
                } else {
#pragma unroll
                    for (int s = 0; s < 2; ++s) if (s < ns) acc = MFMA16(*(const LAS bf16x8*)(RT + (c0 + fr) * 72 + 32 * s + 8 * fq), tf[s], acc);
                    u32x2 p; p.x = pk2(-acc[0], -acc[1]); p.y = pk2(-acc[2], -acc[3]);
                    *(u32x2*)(WNEG + (rowbase + 16 * it + fr) * 128 + (c0 - 128) + 4 * fq) = p; }
            }
        }
        __syncthreads();
    }
}

struct ScanFrag { bf16x8 wn[4], qd[4], qk[2], kt[2]; f32x4 u; float gt; };
DI ScanFrag scan_load(const float* UT, const bf16* WNEG, const bf16* QD, const bf16* KTT, const bf16* QKG, const float* GTOT, int bh, int n, int sl, int w, int et, int jt, int fr, int fq) {
    ScanFrag f; const int cid = bh * 32 + n; const size_t rowbase = (size_t)bh * SEQ + n * 64;
#pragma unroll
    for (int kk = 0; kk < 4; ++kk) { f.wn[kk] = *(const bf16x8*)(WNEG + (rowbase + 16 * jt + fr) * 128 + kk * 32 + fq * 8); f.qd[kk] = *(const bf16x8*)(QD + (rowbase + 16 * jt + fr) * 128 + kk * 32 + fq * 8); }
#pragma unroll
    for (int k2 = 0; k2 < 2; ++k2) { f.qk[k2] = *(const bf16x8*)(QKG + (size_t)cid * 4096 + (16 * jt + fr) * 64 + k2 * 32 + fq * 8); f.kt[k2] = *(const bf16x8*)(KTT + (size_t)cid * 8192 + (16 * w + fr) * 64 + k2 * 32 + fq * 8); }
    f.u = *(const f32x4*)(UT + (size_t)cid * 8192 + (sl * 32 + 16 * et + fr) * 64 + 16 * jt + 4 * fq);
    f.gt = GTOT[cid];
    return f;
}
DI void p4_scan(const Ctx& X, const Args& a) {
    LAS bf16* SL = (LAS bf16*)X.lds;
    LAS bf16* VL = (LAS bf16*)(X.lds + 32 * 136 * 2);
    const float* UT = (const float*)(X.ws + WS_UT); const bf16* WNEG = (const bf16*)(X.ws + WS_WNEG); const bf16* QD = (const bf16*)(X.ws + WS_QD);
    const bf16* KTT = (const bf16*)(X.ws + WS_KTT); const bf16* QKG = (const bf16*)(X.ws + WS_QK); const float* GTOT = (const float*)(X.ws + WS_GTOT);
    bf16* O = (bf16*)(X.ws + WS_O);
    const int fr = X.lane & 15, fq = X.lane >> 4, w = X.wave, et = w & 1, jt = w >> 1;
    for (int unit = X.vcu; unit < NB * AH * 4; unit += X.G) {
        const int bh = unit >> 2, sl = unit & 3, b = bh >> 3, h = bh & 7;
        f32x4 S0 = (f32x4){0.f, 0.f, 0.f, 0.f}, S1 = S0;
        ScanFrag cur = scan_load(UT, WNEG, QD, KTT, QKG, GTOT, bh, 0, sl, w, et, jt, fr, fq);
        for (int n = 0; n < NCH; ++n) {
            const ScanFrag nxt = scan_load(UT, WNEG, QD, KTT, QKG, GTOT, bh, n + 1 < NCH ? n + 1 : n, sl, w, et, jt, fr, fq);
            f32x4 v = cur.u;
            { u32x2 p0, p1; p0.x = pk2(S0[0], S0[1]); p0.y = pk2(S0[2], S0[3]); p1.x = pk2(S1[0], S1[1]); p1.y = pk2(S1[2], S1[3]);
              *(LAS u32x2*)(SL + fr * 136 + 16 * w + 4 * fq) = p0; *(LAS u32x2*)(SL + (16 + fr) * 136 + 16 * w + 4 * fq) = p1; }
            __syncthreads();
            f32x4 o = (f32x4){0.f, 0.f, 0.f, 0.f};
#pragma unroll
            for (int kk = 0; kk < 4; ++kk) { const bf16x8 sf = *(const LAS bf16x8*)(SL + (16 * et + fr) * 136 + kk * 32 + fq * 8);
                v = MFMA16(cur.wn[kk], sf, v); o = MFMA16(sf, cur.qd[kk], o); }
            { u32x2 p; p.x = pk2(v[0], v[1]); p.y = pk2(v[2], v[3]); *(LAS u32x2*)(VL + (16 * et + fr) * 72 + 16 * jt + 4 * fq) = p; }
            __syncthreads();
#pragma unroll
            for (int r = 0; r < 4; ++r) { S0[r] *= cur.gt; S1[r] *= cur.gt; }
#pragma unroll
            for (int k2 = 0; k2 < 2; ++k2) { const bf16x8 v0 = *(const LAS bf16x8*)(VL + fr * 72 + k2 * 32 + fq * 8), v1 = *(const LAS bf16x8*)(VL + (16 + fr) * 72 + k2 * 32 + fq * 8);
                o = MFMA16(et ? v1 : v0, cur.qk[k2], o); S0 = MFMA16(cur.kt[k2], v0, S0); S1 = MFMA16(cur.kt[k2], v1, S1); }
            { u32x2 p; p.x = pk2(o[0], o[1]); p.y = pk2(o[2], o[3]);
              *(u32x2*)(O + (size_t)(b * SEQ + n * 64 + 16 * jt + fr) * D + h * 128 + sl * 32 + 16 * et + 4 * fq) = p; }
            cur = nxt;
        }
        __syncthreads();
    }
}

DI void p13_attn(const Ctx& X, const Args& a) {
    LAS bf16* KL = (LAS bf16*)X.lds;
    LAS bf16* VTL = (LAS bf16*)(X.lds + 256 * 72 * 2);
    const bf16* QN = (const bf16*)(X.ws + WS_QN); const bf16* KN = (const bf16*)(X.ws + WS_KN); const bf16* VT = (const bf16*)(X.ws + WS_VT);
    bf16* O = (bf16*)(X.ws + WS_O);
    const int fr = X.lane & 15, fq = X.lane >> 4;
    for (int unit = X.vcu; unit < NB * 2 * 16; unit += X.G) {
        const int b = unit >> 5, kvh = (unit >> 4) & 1, blk = unit & 15, s0 = blk * 128;
        __syncthreads();
        for (int idx = X.tid; idx < 256 * 8; idx += NTHR) { const int key = idx >> 3, c8 = idx & 7; const int s = s0 - 128 + key;
            u32x4 val = (u32x4){0u, 0u, 0u, 0u};
            if (s >= 0) val = *(const u32x4*)(KN + ((size_t)(b * 2 + kvh) * SEQ + s) * 64 + c8 * 8);
            *(LAS u32x4*)(KL + key * 72 + c8 * 8) = val; }
        for (int idx = X.tid; idx < 64 * 32; idx += NTHR) { const int d = idx >> 5, c8 = idx & 31; const int s = s0 - 128 + c8 * 8;
            u32x4 val = (u32x4){0u, 0u, 0u, 0u};
            if (s >= 0) val = *(const u32x4*)(VT + ((size_t)(b * 2 + kvh) * 64 + d) * SEQ + s);
            *(LAS u32x4*)(VTL + d * 264 + c8 * 8) = val; }
        __syncthreads();
        const int head = kvh * 8 + X.wave; const float sink = a.in[19][head];
        for (int qt = 0; qt < 8; ++qt) {
            const int tq = b * SEQ + s0 + 16 * qt + fr;
            bf16x8 qf[2];
#pragma unroll
            for (int kk = 0; kk < 2; ++kk) qf[kk] = *(const bf16x8*)(QN + (size_t)tq * D + head * 64 + kk * 32 + fq * 8);
            f32x4 st[10];
            float mx = sink;
            const int iq = 16 * qt + fr;
#pragma unroll
            for (int kt = 0; kt < 10; ++kt) { const int ktile = qt + kt, kc = ktile < 15 ? ktile : 15;
                f32x4 acc = (f32x4){0.f, 0.f, 0.f, 0.f};
#pragma unroll
                for (int kk = 0; kk < 2; ++kk) acc = MFMA16(*(const LAS bf16x8*)(KL + (16 * kc + fr) * 72 + kk * 32 + fq * 8), qf[kk], acc);
#pragma unroll
                for (int r = 0; r < 4; ++r) { const int jb = 16 * ktile + 4 * fq + r; const bool ok = (jb > iq) && (jb <= iq + 128) && (blk > 0 || jb >= 128);
                    acc[r] = ok ? acc[r] : -3.0e38f; mx = fmaxf(mx, acc[r]); }
                st[kt] = acc; }
            mx = fmaxf(mx, __shfl_xor(mx, 16)); mx = fmaxf(mx, __shfl_xor(mx, 32));
            float den = 0.f;
#pragma unroll
            for (int kt = 0; kt < 10; ++kt)
#pragma unroll
                for (int r = 0; r < 4; ++r) { const float p = st[kt][r] > -1.0e38f ? __expf(st[kt][r] - mx) : 0.f; st[kt][r] = p; den += p; }
            den += __shfl_xor(den, 16); den += __shfl_xor(den, 32);
            den += __expf(sink - mx);
            const float inv = 1.0f / den;
            f32x4 o[4];
#pragma unroll
            for (int dt = 0; dt < 4; ++dt) o[dt] = (f32x4){0.f, 0.f, 0.f, 0.f};
#pragma unroll
            for (int m = 0; m < 5; ++m) { const int kt0 = qt + 2 * m, kc0 = kt0 < 15 ? kt0 : 15, kc1 = (kt0 + 1) < 15 ? (kt0 + 1) : 15;
                u32x4 pw; pw.x = pk2(st[2 * m][0], st[2 * m][1]); pw.y = pk2(st[2 * m][2], st[2 * m][3]); pw.z = pk2(st[2 * m + 1][0], st[2 * m + 1][1]); pw.w = pk2(st[2 * m + 1][2], st[2 * m + 1][3]);
                const bf16x8 pf = __builtin_bit_cast(bf16x8, pw);
#pragma unroll
                for (int dt = 0; dt < 4; ++dt) { const u32x2 va = *(const LAS u32x2*)(VTL + (16 * dt + fr) * 264 + 16 * kc0 + 4 * fq), vb = *(const LAS u32x2*)(VTL + (16 * dt + fr) * 264 + 16 * kc1 + 4 * fq);
                    const u32x4 vw = (u32x4){va.x, va.y, vb.x, vb.y};
                    o[dt] = MFMA16(__builtin_bit_cast(bf16x8, vw), pf, o[dt]); } }
#pragma unroll
            for (int dt = 0; dt < 4; ++dt) { u32x2 p; p.x = pk2(o[dt][0] * inv, o[dt][1] * inv); p.y = pk2(o[dt][2] * inv, o[dt][3] * inv);
                *(u32x2*)(O + (size_t)tq * D + head * 64 + 16 * dt + 4 * fq) = p; }
        }
    }
}

constexpr int NPH = 19;
#ifndef N_LAUNCHES
#define N_LAUNCHES 1
#endif
__global__ void __launch_bounds__(NTHR, 2) fwd_kernel(Args args) {
    extern __shared__ __attribute__((aligned(16))) unsigned char lds_raw[];
    Ctx X;
    X.lds = (LAS unsigned char*)lds_raw;
    X.tid = threadIdx.x; X.lane = X.tid & 63; X.wave = __builtin_amdgcn_readfirstlane(X.tid >> 6);
    X.G = gridDim.x; { const int bx = blockIdx.x; X.vcu = (X.G % 8 == 0) ? (bx % 8) * (X.G / 8) + bx / 8 : bx; }
    X.gw = X.vcu * NWAVES + X.wave; X.NGW = X.G * NWAVES;
    X.ws = args.ws;
    volatile LAS unsigned* MISC = (volatile LAS unsigned*)(X.lds + MISC_OFF);
    if (X.tid < 64) MISC[X.tid] = 0u;
    __syncthreads();
    unsigned* ctl = (unsigned*)(X.ws + WS_CTL);
    XcdBarrier bar; bar.bar = ctl + CW_BAR; bar.x = 0; bar.st = nullptr;
    if (N_LAUNCHES == 1) bar = xcd_barrier_post(ctl + CW_BAR, MISC + 8);
    const int lo = args.ph_lo, hi = args.ph_hi;
#define IN(k) (lo <= (k) && (k) < hi)
#ifndef REPEAT_MASK
#define REPEAT_MASK 0u
#endif
#define PHASE(k, ...) if (IN(k)) { { __VA_ARGS__ } if ((REPEAT_MASK >> (k)) & 1u) { __VA_ARGS__ } }
#define SEAM(k) do { if (IN(k) && IN((k) + 1)) xcd_barrier(bar); } while (0)
    const Args& a = args;
    bf16* H = (bf16*)(X.ws + WS_H);
    const float* MOD = (const float*)(X.ws + WS_MOD);

    PHASE(0, p0_prologue(X, a);) SEAM(0);
    PHASE(1, p1_norm1(X, a);) SEAM(1);
    PHASE(2, pg8::PlainSched S{H, (const bf16*)(X.ws + WS_WIN_T), 64, 16, X.G, (int)blockIdx.x};
        pg8::EpiBf16 E{(bf16*)(X.ws + WS_PROJ), 4096};
        pg8::gemm_phase(X.lds, S, E);) SEAM(2);
    PHASE(3, p3_prep(X, a);) SEAM(3);
    PHASE(4, p4_scan(X, a);) SEAM(4);
    PHASE(5, p5_onorm(X, a);) SEAM(5);
    PHASE(6, pg8::PlainSched S{(const bf16*)(X.ws + WS_ON), (const bf16*)(X.ws + WS_WOUT_T), 64, 4, X.G, (int)blockIdx.x};
        pg8::EpiResid E{a.in[0], (float*)(X.ws + WS_X1), MOD + 2048};
        pg8::gemm_phase(X.lds, S, E);) SEAM(6);
    PHASE(7, p_norm_router(X, a, 0, (const float*)(X.ws + WS_X1));) SEAM(7);
    PHASE(8, moe_table(X, 0);
        pg8::MoeSched<8, true> S{H, (const bf16*)(X.ws + WS_UP_T), (const int*)(X.ws + WS_LIST), (const LAS int*)(X.lds + TAB_OFF), X.G, X.vcu, (size_t)2048 * 1024};
        pg8::EpiSwiglu E{(bf16*)(X.ws + WS_ACT), a.in[24]};
        pg8::gemm_phase(X.lds, S, E);) SEAM(8);
    PHASE(9, moe_table(X, 0);
        pg8::MoeSched<4, false> S{(const bf16*)(X.ws + WS_ACT), (const bf16*)(X.ws + WS_DOWN_T), (const int*)(X.ws + WS_LIST), (const LAS int*)(X.lds + TAB_OFF), X.G, X.vcu, (size_t)1024 * 1024};
        pg8::EpiDown E{(bf16*)(X.ws + WS_YS), a.in[26], (const int*)(X.ws + WS_LIST)};
        pg8::gemm_phase(X.lds, S, E);) SEAM(9);
    PHASE(10, p10_combine_norm(X, a);) SEAM(10);
    PHASE(11, pg8::KvqSched S{(const bf16*)(X.ws + WS_HKV), (const bf16*)(X.ws + WS_HQ), (const bf16*)(X.ws + WS_KV_T), (const bf16*)(X.ws + WS_WQ_T), X.G, X.vcu};
        pg8::EpiBf16 E{(bf16*)(X.ws + WS_QKV), 1280};
        pg8::gemm_phase(X.lds, S, E);) SEAM(11);
    PHASE(12, p12_qknorm(X, a);) SEAM(12);
    PHASE(13, p13_attn(X, a);) SEAM(13);
    PHASE(14, pg8::PlainSched S{(const bf16*)(X.ws + WS_O), (const bf16*)(X.ws + WS_BWOUT_T), 64, 4, X.G, (int)blockIdx.x};
        pg8::EpiResid E{(const float*)(X.ws + WS_X2), (float*)(X.ws + WS_X1), MOD + 6144 + 2048};
        pg8::gemm_phase(X.lds, S, E);) SEAM(14);
    PHASE(15, p_norm_router(X, a, 1, (const float*)(X.ws + WS_X1));) SEAM(15);
    PHASE(16, moe_table(X, 1);
        pg8::MoeSched<8, true> S{H, (const bf16*)(X.ws + WS_UP_T) + (size_t)32 * 2048 * 1024, (const int*)(X.ws + WS_LIST), (const LAS int*)(X.lds + TAB_OFF), X.G, X.vcu, (size_t)2048 * 1024};
        pg8::EpiSwiglu E{(bf16*)(X.ws + WS_ACT), a.in[24] + 32 * 2048};
        pg8::gemm_phase(X.lds, S, E);) SEAM(16);
    PHASE(17, moe_table(X, 1);
        pg8::MoeSched<4, false> S{(const bf16*)(X.ws + WS_ACT), (const bf16*)(X.ws + WS_DOWN_T) + (size_t)32 * 1024 * 1024, (const int*)(X.ws + WS_LIST), (const LAS int*)(X.lds + TAB_OFF), X.G, X.vcu, (size_t)1024 * 1024};
        pg8::EpiDown E{(bf16*)(X.ws + WS_YS), a.in[26] + 32 * 1024, (const int*)(X.ws + WS_LIST)};
        pg8::gemm_phase(X.lds, S, E);) SEAM(17);
    PHASE(18, p18_final(X, a);)
#undef IN
#undef SEAM
}

extern "C" void kernel_launch(void* const* d_in, const int* in_sizes, int n_in, void* d_out, int out_size, void* d_ws, size_t ws_size, hipStream_t stream) {
    static int grid = 0;
    if (grid == 0) {
        if (n_in != 27 || out_size != T * D || ws_size < WS_END) { fprintf(stderr, "kernel_launch: unexpected problem (n_in %d, out %d, ws %zu)\n", n_in, out_size, ws_size); grid = -1; return; }
        int dev = 0, cus = 0, per_cu = 0;
        if (hipGetDevice(&dev) != hipSuccess || hipDeviceGetAttribute(&cus, hipDeviceAttributeMultiprocessorCount, dev) != hipSuccess) { grid = -1; return; }
        if (hipFuncSetAttribute((const void*)fwd_kernel, hipFuncAttributeMaxDynamicSharedMemorySize, LDS_BYTES) != hipSuccess) { fprintf(stderr, "kernel_launch: hipFuncSetAttribute failed\n"); grid = -1; return; }
        if (hipOccupancyMaxActiveBlocksPerMultiprocessor(&per_cu, (const void*)fwd_kernel, NTHR, LDS_BYTES) != hipSuccess || per_cu < 1) { fprintf(stderr, "kernel_launch: occupancy query says %d\n", per_cu); (void)hipGetLastError(); }
        grid = cus;
    }
    if (grid < 0) return;
    (void)hipMemsetAsync((char*)d_ws + WS_CTL, 0, CTL_ZERO_BYTES, stream);
    Args a{};
    for (int i = 0; i < 27; ++i) a.in[i] = (const float*)d_in[i];
    a.pos = (const int*)d_in[2]; a.out = (float*)d_out; a.ws = (unsigned char*)d_ws;
    if (N_LAUNCHES == 1) { a.ph_lo = 0; a.ph_hi = NPH; hipLaunchKernelGGL(fwd_kernel, dim3(grid), dim3(NTHR), LDS_BYTES, stream, a); }
    else for (int p = 0; p < NPH; ++p) { a.ph_lo = p; a.ph_hi = p + 1; hipLaunchKernelGGL(fwd_kernel, dim3(grid), dim3(NTHR), LDS_BYTES, stream, a); }
}
```

```cpp
#include <hip/hip_runtime.h>
#include <cstdio>
#include <cstdint>

#define GAS __attribute__((address_space(1)))
#define LAS __attribute__((address_space(3)))
#define DI __device__ __forceinline__
typedef unsigned short bf16;
typedef short bf16x8 __attribute__((ext_vector_type(8)));
typedef short bf16x4 __attribute__((ext_vector_type(4)));
typedef float f32x4 __attribute__((ext_vector_type(4)));
typedef float f32x2 __attribute__((ext_vector_type(2)));
typedef unsigned u32x4 __attribute__((ext_vector_type(4)));
typedef unsigned u32x2 __attribute__((ext_vector_type(2)));

constexpr int NB = 8, SEQ = 2048, D = 1024, T = NB * SEQ;
constexpr int AH = 8, NCH = SEQ / 64;
constexpr int NE = 32, LISTCAP = 16384;
constexpr int MODW = 14336;
constexpr int NWAVES = 8, NTHR = 512;
constexpr float EPS = 1e-6f;

constexpr size_t MiB = 1u << 20;
constexpr size_t WS_CTL = 0, CTL_ZERO_BYTES = 1 * MiB;
constexpr size_t WS_MOD = 1 * MiB, WS_ROPE = 2 * MiB, WS_AB = 3 * MiB, WS_RGATE = 4 * MiB, WS_LIST = 5 * MiB, WS_GTOT = 7 * MiB;
constexpr size_t WS_WIN_T = 8 * MiB, WS_WOUT_T = 16 * MiB, WS_KV_T = 18 * MiB, WS_WQ_T = 19 * MiB, WS_BWOUT_T = 21 * MiB;
constexpr size_t WS_UP_T = 32 * MiB, WS_DOWN_T = 288 * MiB;
constexpr size_t WS_H = 416 * MiB, WS_HQ = 448 * MiB, WS_HKV = 480 * MiB, WS_PROJ = 512 * MiB;
constexpr size_t WS_UT = 640 * MiB, WS_WNEG = 704 * MiB, WS_QD = 736 * MiB, WS_KTT = 768 * MiB, WS_QK = 800 * MiB;
constexpr size_t WS_O = 816 * MiB, WS_ON = 848 * MiB, WS_X1 = 880 * MiB, WS_X2 = 944 * MiB;
constexpr size_t WS_ACT = 1008 * MiB, WS_YS = 1152 * MiB, WS_QKV = 1280 * MiB, WS_QN = 1320 * MiB, WS_KN = 1352 * MiB, WS_VT = 1356 * MiB;
constexpr size_t WS_END = 1360 * MiB;
constexpr int CW_CNT = 1024;
constexpr int CW_BAR = 4096;

constexpr int RING_BYTES = 131072;
constexpr int LDS_BYTES = 147456;
constexpr int MISC_OFF = LDS_BYTES - 2048;
constexpr int TAB_OFF = MISC_OFF + 256;

DI unsigned f2bf(float f) { unsigned u = __builtin_bit_cast(unsigned, f); return (u + 0x7fffu + ((u >> 16) & 1u)) >> 16; }
DI unsigned pk2(float lo, float hi) { return f2bf(lo) | (f2bf(hi) << 16); }
DI float bf2f(unsigned b) { return __builtin_bit_cast(float, b << 16); }
DI float bflo(unsigned w) { return __builtin_bit_cast(float, w << 16); }
DI float bfhi(unsigned w) { return __builtin_bit_cast(float, w & 0xffff0000u); }
DI float wave_sum(float v) {
#pragma unroll
    for (int o = 1; o < 64; o <<= 1) v += __shfl_xor(v, o);
    return v;
}
DI float sigmoidf_(float x) { return 1.f / (1.f + __expf(-x)); }
DI float siluf_(float x) { return x / (1.f + __expf(-x)); }
#define LDS_WAIT() asm volatile("s_waitcnt lgkmcnt(0)" ::: "memory")
#define VM_WAIT() asm volatile("s_waitcnt vmcnt(0)" ::: "memory")
#define BAR_LDS() do { asm volatile("s_waitcnt lgkmcnt(0)" ::: "memory"); __builtin_amdgcn_s_barrier(); asm volatile("" ::: "memory"); } while (0)
#define MFMA16(a, b, c) __builtin_amdgcn_mfma_f32_16x16x32_bf16((a), (b), (c), 0, 0, 0)

#define XB_TMO      128
#define XB_XCNT(j)  (256  + 64 * (j))
#define XB_XSUB(j)  (1280 + 64 * (j))
#define XB_XGEN(j)  (2304 + 64 * (j))
#define XB_TOP      3328
#define XB_TOPGEN   3392
#define XCD_BAR_WORDS 3456
#define XB_SPIN_CAP (1u << 18)
__device__ __forceinline__ unsigned xb_ld(unsigned* p)              { return __hip_atomic_load(p, __ATOMIC_RELAXED, __HIP_MEMORY_SCOPE_AGENT); }
__device__ __forceinline__ unsigned xb_add(unsigned* p, unsigned v) { return __hip_atomic_fetch_add(p, v, __ATOMIC_RELAXED, __HIP_MEMORY_SCOPE_AGENT); }
__device__ __forceinline__ unsigned xb_xcc_id() { return (unsigned)__builtin_amdgcn_s_getreg((3 << 11) | 20) & 0xFu; }
#define XB_SPIN(cond, bar) do { unsigned _sp = 0; while (cond) { __builtin_amdgcn_s_sleep(1); \
    if ((++_sp & 255u) == 0u) { if (xb_ld(&(bar)[XB_TMO])) break; if (_sp > XB_SPIN_CAP) { atomicAdd(&(bar)[XB_TMO], 1u); break; } } } } while (0)
struct XcdBarrier { unsigned* bar; unsigned x; volatile LAS unsigned* st; };
__device__ __forceinline__ XcdBarrier xcd_barrier_post(unsigned* bar, volatile LAS unsigned* st) {
    XcdBarrier b; b.bar = bar; b.x = xb_xcc_id(); b.st = st;
    if (threadIdx.x == 0) (void)xb_add(&bar[XB_XCNT(b.x)], 1u);
    return b;
}
__device__ __forceinline__ void xcd_barrier_complete(unsigned* bar, unsigned x, unsigned& nloc, unsigned& nx) {
    const unsigned G = gridDim.x * gridDim.y * gridDim.z;
    unsigned sum, cnt, mine, sp = 0u;
    for (;;) {
        sum = 0u; cnt = 0u; mine = 0u;
#pragma unroll
        for (unsigned j = 0; j < 16; ++j) { const unsigned c = xb_ld(&bar[XB_XCNT(j)]); sum += c; cnt += (c > 0u) ? 1u : 0u; mine = (j == x) ? c : mine; }
        if (sum == G) break;
        __builtin_amdgcn_s_sleep(1);
        if ((++sp & 255u) == 0u) { if (xb_ld(&bar[XB_TMO])) break; if (sp > XB_SPIN_CAP) { atomicAdd(&bar[XB_TMO], 1u); break; } }
    }
    nloc = mine > 0u ? mine : 1u; nx = cnt > 0u ? cnt : 1u;
}
__device__ __forceinline__ void xcd_barrier(const XcdBarrier& b) {
    asm volatile("s_waitcnt vmcnt(0)" ::: "memory");
    __syncthreads();
    if (threadIdx.x == 0) {
        unsigned* bar = b.bar;
        __builtin_amdgcn_s_waitcnt(0);
        unsigned nloc = b.st[0], nx = b.st[1];
        if (nloc == 0u) { xcd_barrier_complete(bar, b.x, nloc, nx); b.st[0] = nloc; b.st[1] = nx; }
        const unsigned old = xb_add(&bar[XB_XSUB(b.x)], 1u);
        const unsigned gen = old / nloc;
        if (old + 1u == (gen + 1u) * nloc) {
            __builtin_amdgcn_fence(__ATOMIC_RELEASE, "agent");
            asm volatile("s_waitcnt vmcnt(0)" ::: "memory");
            const unsigned og = xb_add(&bar[XB_TOP], 1u);
            const unsigned tg = og / nx;
            if (og + 1u == (tg + 1u) * nx) xb_add(&bar[XB_TOPGEN], 1u);
            else XB_SPIN(xb_ld(&bar[XB_TOPGEN]) == tg, bar);
            __builtin_amdgcn_fence(__ATOMIC_ACQUIRE, "agent");
            xb_add(&bar[XB_XGEN(b.x)], 1u);
            asm volatile("s_waitcnt vmcnt(0)" ::: "memory");
        } else {
            XB_SPIN(xb_ld(&bar[XB_XGEN(b.x)]) == gen, bar);
            __builtin_amdgcn_fence(__ATOMIC_ACQUIRE, "agent");
            asm volatile("s_waitcnt vmcnt(0)" ::: "memory");
        }
    }
    __syncthreads();
}

namespace pg8 {
constexpr int BM = 256, BK = 64, HALF = 128, HTB = HALF * BK * 2, KD = 1024;
__host__ __device__ __forceinline__ int lds_byte(int r, int c) { const int st = (r >> 4) * 2 + (c >> 5), rr = r & 15, cc = c & 31, ob = rr * 64 + cc * 2; return st * 1024 + (ob ^ (((ob >> 9) & 1) << 5)); }
__host__ __device__ __forceinline__ void stage_rc(int b, int& R, int& C) { const int st = b / 1024, sb = b % 1024, swz = sb ^ (((sb >> 9) & 1) << 5); R = (st >> 1) * 16 + swz / 64; C = (st & 1) * 32 + (swz % 64) / 2; }
__host__ __device__ __forceinline__ int perm32(int rho) { const int n = rho >> 4, i = rho & 15; return 8 * (i >> 2) + 4 * n + (i & 3); }
struct Unit { int pm, pn, e, rows, mt; };
__device__ __forceinline__ unsigned cvt_pk_bf16(float lo, float hi) { unsigned r; asm volatile("v_cvt_pk_bf16_f32 %0, %1, %2" : "=v"(r) : "v"(lo), "v"(hi)); return r; }

template <class Epi, class Sched>
__device__ __forceinline__ void gemm_phase(LAS unsigned char* lds, const Sched& S, const Epi& E) {
    const int tid = threadIdx.x, wid = __builtin_amdgcn_readfirstlane(tid >> 6), lane = tid & 63, wr = wid >> 2, wc = wid & 3, fr = lane & 15, fq = lane >> 4;
    constexpr int K = KD, nt = K / BK;
    int Rr[2], Cc[2]; unsigned voffB[2];
#pragma unroll
    for (int i = 0; i < 2; ++i) { stage_rc(tid * 16 + i * 8192, Rr[i], Cc[i]); const int Rb = Epi::PERM ? ((Rr[i] & ~31) + perm32(Rr[i] & 31)) : Rr[i]; voffB[i] = (unsigned)(Rb * K + Cc[i]) * 2u; }
    const size_t kstep = (size_t)(BK * 2);
    const size_t hstep = (size_t)HALF * K * 2;
    const unsigned ldsw = (unsigned)wid * 1024u;
    const int aoff = lds_byte(wr * 64 + fr, fq * 8), boff = lds_byte(wc * 32 + fr, fq * 8);
#define PG8_SA(b, h) (((b) * 2 + (h)) * HTB)
#define PG8_SB(b, h) ((4 + (b) * 2 + (h)) * HTB)
#define PG8_STAGE(bufoff, gbase, voff) do { _Pragma("unroll") for (int _i = 0; _i < 2; ++_i) \
        __builtin_amdgcn_global_load_lds((const unsigned*)((const char*)(gbase) + (voff)[_i]), (LAS unsigned*)(lds + (bufoff) + ldsw + _i * 8192), 16, 0, 0); } while (0)
#define PG8_LDA(dst, b, h) do { _Pragma("unroll") for (int m = 0; m < 4; ++m) _Pragma("unroll") for (int k = 0; k < 2; ++k) dst[m][k] = *(const LAS bf16x8*)(lds + PG8_SA(b, h) + aoff + m * 2048 + k * 1024); } while (0)
#define PG8_LDB(dst, b, h) do { _Pragma("unroll") for (int n = 0; n < 2; ++n) _Pragma("unroll") for (int k = 0; k < 2; ++k) dst[n][k] = *(const LAS bf16x8*)(lds + PG8_SB(b, h) + boff + n * 2048 + k * 1024); } while (0)
#define PG8_MMA(ai, bj, At, Bt) do { __builtin_amdgcn_s_setprio(1); _Pragma("unroll") for (int m = 0; m < 4; ++m) _Pragma("unroll") for (int n = 0; n < 2; ++n) _Pragma("unroll") for (int k = 0; k < 2; ++k) \
        acc[ai][bj][m][n] = __builtin_amdgcn_mfma_f32_16x16x32_bf16(Bt[n][k], At[m][k], acc[ai][bj][m][n], 0, 0, 0); __builtin_amdgcn_s_setprio(0); } while (0)
#define PG8_WAIT_V(n) asm volatile("s_waitcnt vmcnt(" #n ")" ::: "memory")
#define PG8_WAIT_L(n) asm volatile("s_waitcnt lgkmcnt(" #n ")" ::: "memory")
#define PG8_BAR __builtin_amdgcn_s_barrier()
#define PG8_SCHED __builtin_amdgcn_sched_barrier(0)
    Unit cur, nxt; int ui = 0;
    if (!S.next(0, cur)) return;
    f32x4 acc[2][2][4][2];
#pragma unroll
    for (int a = 0; a < 2; ++a)
#pragma unroll
        for (int b = 0; b < 2; ++b)
#pragma unroll
            for (int m = 0; m < 4; ++m)
#pragma unroll
                for (int n = 0; n < 2; ++n) acc[a][b][m][n] = (f32x4){0.f, 0.f, 0.f, 0.f};
    bf16x8 At[4][2], B0[2][2], B1[2][2];
    unsigned va[2][2], nva[2][2];
#pragma unroll
    for (int h = 0; h < 2; ++h)
#pragma unroll
        for (int i = 0; i < 2; ++i) va[h][i] = S.a_off(cur, h * HALF + Rr[i], Cc[i]);
    const char* cA = S.a_base(cur); const char* cB = S.b_base(cur);
    PG8_STAGE(PG8_SB(0, 0), cB, voffB); PG8_STAGE(PG8_SB(0, 1), cB + hstep, voffB); PG8_STAGE(PG8_SA(0, 0), cA, va[0]); PG8_STAGE(PG8_SA(0, 1), cA, va[1]);
    if (wr == 1) PG8_BAR;
    PG8_WAIT_V(2); PG8_BAR;
    PG8_STAGE(PG8_SB(1, 0), cB + kstep, voffB); PG8_STAGE(PG8_SA(1, 0), cA + kstep, va[0]); PG8_STAGE(PG8_SB(1, 1), cB + hstep + kstep, voffB);
    PG8_WAIT_V(6); PG8_BAR;
    for (;;) {
        const bool has_next = S.next(ui + 1, nxt);
        const char* nA = cA; const char* nB = cB;
#pragma unroll
        for (int h = 0; h < 2; ++h)
#pragma unroll
            for (int i = 0; i < 2; ++i) nva[h][i] = va[h][i];
        if (has_next) {
            nA = S.a_base(nxt); nB = S.b_base(nxt);
#pragma unroll
            for (int h = 0; h < 2; ++h)
#pragma unroll
                for (int i = 0; i < 2; ++i) nva[h][i] = S.a_off(nxt, h * HALF + Rr[i], Cc[i]);
        }
        asm volatile("" : "+v"(nva[0][0]), "+v"(nva[0][1]), "+v"(nva[1][0]), "+v"(nva[1][1]));
        for (int t = 0; t < nt; t += 2) {
            const bool last = (t == nt - 2);
            const char* a1 = cA + (size_t)(t + 1) * kstep;
            const char* a2 = last ? nA : cA + (size_t)(t + 2) * kstep; const char* b2 = last ? nB : cB + (size_t)(t + 2) * kstep;
            const char* a3 = a2 + kstep; const char* b3 = b2 + kstep;
            unsigned v2[2][2];
#pragma unroll
            for (int h = 0; h < 2; ++h)
#pragma unroll
                for (int i = 0; i < 2; ++i) v2[h][i] = last ? nva[h][i] : va[h][i];
            PG8_LDB(B0, 0, 0); PG8_LDB(B1, 0, 1); PG8_SCHED; PG8_LDA(At, 0, 0); PG8_STAGE(PG8_SA(1, 1), a1, va[1]);
            PG8_WAIT_V(8); PG8_WAIT_L(0); PG8_BAR; PG8_MMA(0, 0, At, B0); PG8_MMA(0, 1, At, B1); PG8_BAR; PG8_SCHED;
            PG8_LDA(At, 0, 1); PG8_STAGE(PG8_SB(0, 0), b2, voffB); PG8_STAGE(PG8_SB(0, 1), b2 + hstep, voffB); PG8_STAGE(PG8_SA(0, 0), a2, v2[0]);
            PG8_WAIT_V(8); PG8_WAIT_L(0); PG8_BAR; PG8_MMA(1, 0, At, B0); PG8_MMA(1, 1, At, B1); PG8_BAR; PG8_SCHED;
            PG8_LDB(B0, 1, 0); PG8_LDB(B1, 1, 1); PG8_SCHED; PG8_LDA(At, 1, 0); PG8_STAGE(PG8_SA(0, 1), a2, v2[1]);
            PG8_WAIT_V(8); PG8_WAIT_L(0); PG8_BAR; PG8_MMA(0, 0, At, B0); PG8_MMA(0, 1, At, B1); PG8_BAR; PG8_SCHED;
            PG8_LDA(At, 1, 1); PG8_STAGE(PG8_SB(1, 0), b3, voffB); PG8_STAGE(PG8_SB(1, 1), b3 + hstep, voffB); PG8_STAGE(PG8_SA(1, 0), a3, v2[0]);
            PG8_WAIT_V(8); PG8_WAIT_L(0); PG8_BAR; PG8_MMA(1, 0, At, B0); PG8_MMA(1, 1, At, B1); PG8_BAR; PG8_SCHED;
        }
        E(acc, cur, wr, wc, fr, fq);
        if (!has_next) break;
#pragma unroll
        for (int a = 0; a < 2; ++a)
#pragma unroll
            for (int b = 0; b < 2; ++b)
#pragma unroll
                for (int m = 0; m < 4; ++m)
#pragma unroll
                    for (int n = 0; n < 2; ++n) acc[a][b][m][n] = (f32x4){0.f, 0.f, 0.f, 0.f};
        cur = nxt; cA = nA; cB = nB; ++ui;
#pragma unroll
        for (int h = 0; h < 2; ++h)
#pragma unroll
            for (int i = 0; i < 2; ++i) va[h][i] = nva[h][i];
    }
    PG8_WAIT_V(0);
    if (wr == 0) PG8_BAR;
    PG8_BAR;
#undef PG8_SA
#undef PG8_SB
#undef PG8_STAGE
#undef PG8_LDA
#undef PG8_LDB
#undef PG8_MMA
#undef PG8_WAIT_V
#undef PG8_WAIT_L
#undef PG8_BAR
#undef PG8_SCHED
}

struct PlainSched {
    const bf16* A; const bf16* Bt; int nM, nN, G, c;
    __device__ __forceinline__ bool next(int i, Unit& u) const {
        const int nwg = nM * nN; const long L = (long)i * G + c; if (L >= nwg) return false;
        int wgid = (int)L; { const int q = nwg / 8, r = nwg % 8, xcd = wgid % 8, off = wgid / 8; wgid = (xcd < r ? xcd * (q + 1) : r * (q + 1) + (xcd - r) * q) + off; }
        const int nig = 8 * nN, gid = wgid / nig, fm = gid * 8, gsz = (nM - fm) < 8 ? (nM - fm) : 8;
        u.pm = fm + ((wgid % nig) % gsz); u.pn = (wgid % nig) / gsz; u.e = 0; u.rows = 256; u.mt = 0; return true;
    }
    __device__ __forceinline__ const char* a_base(const Unit& u) const { return (const char*)A + (size_t)u.pm * (256 * KD * 2); }
    __device__ __forceinline__ const char* b_base(const Unit& u) const { return (const char*)Bt + (size_t)u.pn * (256 * KD * 2); }
    __device__ __forceinline__ unsigned a_off(const Unit&, int row, int col) const { return (unsigned)(row * KD + col) * 2u; }
};
struct KvqSched {
    const bf16* Akv; const bf16* Aq; const bf16* Bkv; const bf16* Bq; int G, c;
    __device__ __forceinline__ bool next(int i, Unit& u) const {
        const int L = i * G + c; if (L >= 64 * 5) return false;
        u.pm = L / 5; u.pn = L % 5; u.e = 0; u.rows = 256; u.mt = 0; return true;
    }
    __device__ __forceinline__ const char* a_base(const Unit& u) const { return (const char*)(u.pn == 0 ? Akv : Aq) + (size_t)u.pm * (256 * KD * 2); }
    __device__ __forceinline__ const char* b_base(const Unit& u) const { return u.pn == 0 ? (const char*)Bkv : (const char*)Bq + (size_t)(u.pn - 1) * (256 * KD * 2); }
    __device__ __forceinline__ unsigned a_off(const Unit&, int row, int col) const { return (unsigned)(row * KD + col) * 2u; }
};
template <int NPN, bool GATHER>
struct MoeSched {
    const bf16* A; const bf16* Bt; const int* list; const LAS int* tab; int G, c; size_t bstride;
    __device__ __forceinline__ bool next(int i, Unit& u) const {
        const int ntiles = tab[32 + 32]; const int L = i * G + c; const int tile = L / NPN;
        if (tile >= ntiles) return false;
        const int e = tab[80 + tile]; u.pm = tile; u.pn = L % NPN; u.e = e; u.mt = tile - tab[32 + e];
        const int rem = tab[e] - u.mt * 256; u.rows = rem < 256 ? rem : 256; return true;
    }
    __device__ __forceinline__ const char* a_base(const Unit& u) const { return GATHER ? (const char*)A : (const char*)A + (size_t)u.pm * (256 * KD * 2); }
    __device__ __forceinline__ const char* b_base(const Unit& u) const { return (const char*)(Bt + (size_t)u.e * bstride) + (size_t)u.pn * (256 * KD * 2); }
    __device__ __forceinline__ unsigned a_off(const Unit& u, int row, int col) const {
        if (!GATHER) return (unsigned)(row * KD + col) * 2u;
        const int tok = row < u.rows ? (list[u.e * LISTCAP + u.mt * 256 + row] >> 2) : 0;
        return (unsigned)(tok * KD + col) * 2u;
    }
};

struct EpiBf16 {
    static constexpr bool PERM = true;
    bf16* O; int ldc;
    __device__ __forceinline__ void operator()(const f32x4 (&acc)[2][2][4][2], const Unit& u, int wr, int wc, int fr, int fq) const {
        const int row0 = u.pm * BM + wr * 64 + fr, col0 = u.pn * BM + wc * 32 + 8 * fq;
#pragma unroll
        for (int ai = 0; ai < 2; ++ai)
#pragma unroll
            for (int m = 0; m < 4; ++m) { bf16* rowp = O + (size_t)(row0 + ai * HALF + m * 16) * ldc + col0;
#pragma unroll
                for (int bj = 0; bj < 2; ++bj) { const f32x4 v0 = acc[ai][bj][m][0], v1 = acc[ai][bj][m][1];
                    u32x4 w; w.x = cvt_pk_bf16(v0[0], v0[1]); w.y = cvt_pk_bf16(v0[2], v0[3]); w.z = cvt_pk_bf16(v1[0], v1[1]); w.w = cvt_pk_bf16(v1[2], v1[3]);
                    *(u32x4*)(rowp + bj * HALF) = w; } }
    }
};
struct EpiResid {
    static constexpr bool PERM = false;
    const float* base; float* out; const float* gate;
    __device__ __forceinline__ void operator()(const f32x4 (&acc)[2][2][4][2], const Unit& u, int wr, int wc, int fr, int fq) const {
        const int row0 = u.pm * BM + wr * 64 + fr, col0 = u.pn * BM + wc * 32 + 4 * fq;
        const float* gp = gate + (size_t)(u.pm / 8) * MODW + col0;
        f32x4 gv[2][2];
#pragma unroll
        for (int bj = 0; bj < 2; ++bj)
#pragma unroll
            for (int n = 0; n < 2; ++n) gv[bj][n] = *(const f32x4*)(gp + bj * HALF + n * 16);
#pragma unroll
        for (int ai = 0; ai < 2; ++ai)
#pragma unroll
            for (int m = 0; m < 4; ++m) { const size_t off = (size_t)(row0 + ai * HALF + m * 16) * D + col0;
#pragma unroll
                for (int bj = 0; bj < 2; ++bj)
#pragma unroll
                    for (int n = 0; n < 2; ++n) { const f32x4 bs = *(const f32x4*)(base + off + bj * HALF + n * 16);
                        *(f32x4*)(out + off + bj * HALF + n * 16) = bs + gv[bj][n] * acc[ai][bj][m][n]; }
                asm volatile("" ::: "memory"); }
    }
};
struct EpiSwiglu {
    static constexpr bool PERM = true;
    bf16* act; const float* upb;
    __device__ __forceinline__ void operator()(const f32x4 (&acc)[2][2][4][2], const Unit& u, int wr, int wc, int fr, int fq) const {
        const int row0 = u.pm * BM + wr * 64 + fr, j0 = u.pn * HALF + wc * 32 + 8 * fq;
        const float* bp = upb + (size_t)u.e * 2048 + j0;
        f32x4 bg[2], bl[2];
#pragma unroll
        for (int n = 0; n < 2; ++n) { bg[n] = *(const f32x4*)(bp + 4 * n); bl[n] = *(const f32x4*)(bp + 1024 + 4 * n); }
#pragma unroll
        for (int ai = 0; ai < 2; ++ai)
#pragma unroll
            for (int m = 0; m < 4; ++m) { float o[8];
#pragma unroll
                for (int n = 0; n < 2; ++n) { const f32x4 g = acc[ai][0][m][n] + bg[n], l = acc[ai][1][m][n] + bl[n];
#pragma unroll
                    for (int j = 0; j < 4; ++j) { const float gg = fminf(g[j], 7.0f), ll = fminf(fmaxf(l[j], -7.0f), 7.0f);
                        o[4 * n + j] = gg * (1.f / (1.f + __expf(-1.702f * gg))) * (ll + 1.0f); } }
                u32x4 w; w.x = cvt_pk_bf16(o[0], o[1]); w.y = cvt_pk_bf16(o[2], o[3]); w.z = cvt_pk_bf16(o[4], o[5]); w.w = cvt_pk_bf16(o[6], o[7]);
                *(u32x4*)(act + (size_t)(row0 + ai * HALF + m * 16) * 1024 + j0) = w; }
    }
};
struct EpiDown {
    static constexpr bool PERM = true;
    bf16* ys; const float* dnb; const int* list;
    __device__ __forceinline__ void operator()(const f32x4 (&acc)[2][2][4][2], const Unit& u, int wr, int wc, int fr, int fq) const {
        const int r0 = wr * 64 + fr, col0 = u.pn * BM + wc * 32 + 8 * fq;
        const float* bp = dnb + (size_t)u.e * 1024 + col0;
        f32x4 bv[2][2];
#pragma unroll
        for (int bj = 0; bj < 2; ++bj)
#pragma unroll
            for (int n = 0; n < 2; ++n) bv[bj][n] = *(const f32x4*)(bp + bj * HALF + 4 * n);
        const int* lp = list + u.e * LISTCAP + u.mt * 256;
#pragma unroll
        for (int ai = 0; ai < 2; ++ai)
#pragma unroll
            for (int m = 0; m < 4; ++m) { const int r = r0 + ai * HALF + m * 16;
                if (r < u.rows) { const int slot = lp[r]; bf16* rowp = ys + (size_t)slot * 1024 + col0;
#pragma unroll
                    for (int bj = 0; bj < 2; ++bj) { const f32x4 v0 = acc[ai][bj][m][0] + bv[bj][0], v1 = acc[ai][bj][m][1] + bv[bj][1];
                        u32x4 w; w.x = cvt_pk_bf16(v0[0], v0[1]); w.y = cvt_pk_bf16(v0[2], v0[3]); w.z = cvt_pk_bf16(v1[0], v1[1]); w.w = cvt_pk_bf16(v1[2], v1[3]);
                        *(u32x4*)(rowp + bj * HALF) = w; } } }
    }
};
}

struct Args { const float* in[27]; const int* pos; float* out; unsigned char* ws; int ph_lo, ph_hi; };

struct Ctx {
    LAS unsigned char* lds; int tid, lane, wave, vcu, G, gw, NGW;
    unsigned char* ws;
};

DI void tr_item(const float* W, int ldw, int k0, int n0, bf16* WT, int dst_row0, LAS float* scr, int lane) {
    float ld[32];
#pragma unroll
    for (int i = 0; i < 32; ++i) ld[i] = __builtin_nontemporal_load(W + (size_t)(k0 + 2 * i + (lane >> 5)) * ldw + n0 + (lane & 31));
#pragma unroll
    for (int i = 0; i < 32; ++i) scr[(2 * i + (lane >> 5)) * 33 + (lane & 31)] = ld[i];
    LDS_WAIT(); asm volatile("" ::: "memory");
    const int c = lane & 7;
#pragma unroll
    for (int j = 0; j < 4; ++j) { const int n = (lane >> 3) + 8 * j; const LAS float* s = scr + (8 * c) * 33 + n;
        u32x4 o; o.x = pk2(s[0 * 33], s[1 * 33]); o.y = pk2(s[2 * 33], s[3 * 33]); o.z = pk2(s[4 * 33], s[5 * 33]); o.w = pk2(s[6 * 33], s[7 * 33]);
        *(GAS u32x4*)(WT + (size_t)(dst_row0 + n) * 1024 + k0 + 8 * c) = o; }
    LDS_WAIT(); asm volatile("" ::: "memory");
}

DI void p0_prologue(const Ctx& X, const Args& a) {
    {
        LAS float* CA = (LAS float*)X.lds;
        LAS float* RED = (LAS float*)(X.lds + 32768);
        const float* c = a.in[1];
        for (int idx = X.tid; idx < 8192; idx += NTHR) { const int b = idx >> 10, d = idx & 1023; CA[d * 8 + b] = siluf_(c[idx]); }
        __syncthreads();
        float* MOD = (float*)(X.ws + WS_MOD);
        for (int g = X.vcu; g < 224; g += X.G) {
            const float* W; const float* bias; int ld, outcol;
            if (g < 96) { W = a.in[3] + 64 * g; ld = 6144; bias = a.in[4] + 64 * g; outcol = 64 * g; }
            else if (g < 192) { W = a.in[3] + (size_t)1024 * 6144 + 64 * (g - 96); ld = 6144; bias = a.in[4] + 6144 + 64 * (g - 96); outcol = 6144 + 64 * (g - 96); }
            else { W = a.in[12] + 64 * (g - 192); ld = 2048; bias = a.in[13] + 64 * (g - 192); outcol = 12288 + 64 * (g - 192); }
            float acc[8];
#pragma unroll
            for (int b = 0; b < 8; ++b) acc[b] = 0.f;
            const int d0 = X.wave * 128;
#pragma unroll 8
            for (int dd = 0; dd < 128; ++dd) { const int d = d0 + dd; const float wv = W[(size_t)d * ld + X.lane];
                const f32x4 c0 = *(const LAS f32x4*)(CA + d * 8), c1 = *(const LAS f32x4*)(CA + d * 8 + 4);
                acc[0] += c0[0] * wv; acc[1] += c0[1] * wv; acc[2] += c0[2] * wv; acc[3] += c0[3] * wv;
                acc[4] += c1[0] * wv; acc[5] += c1[1] * wv; acc[6] += c1[2] * wv; acc[7] += c1[3] * wv; }
#pragma unroll
            for (int b = 0; b < 8; ++b) RED[(X.wave * 8 + b) * 64 + X.lane] = acc[b];
            __syncthreads();
            { const int b = X.tid >> 6, col = X.tid & 63; float s = bias[col];
#pragma unroll
              for (int w = 0; w < 8; ++w) s += RED[(w * 8 + b) * 64 + col];
              MOD[(size_t)b * MODW + outcol + col] = s; }
            __syncthreads();
        }
    }
    {
        float* ROPE = (float*)(X.ws + WS_ROPE);
        for (int idx = X.gw * 64 + X.lane; idx < T * 8; idx += X.NGW * 64) {
            const int t = idx >> 3, i = idx & 7;
            const float invf = i == 0 ? 1.0f : i == 1 ? 0.19392274f : i == 2 ? 0.03760603f : i == 3 ? 0.0072926646f : i == 4 ? 0.0014142136f : i == 5 ? 0.0002742482f : i == 6 ? 5.3182957e-05f : 1.0313385e-05f;
            const float ang = (float)a.pos[t] * invf;
            double rev = (double)ang * 0.15915494309189533577; rev -= __builtin_rint(rev);
            const float fr = (float)rev;
            ROPE[t * 16 + i] = __builtin_amdgcn_cosf(fr); ROPE[t * 16 + 8 + i] = __builtin_amdgcn_sinf(fr);
        }
    }
    {
        LAS float* scr = (LAS float*)(X.lds + 65536 + X.wave * 8448);
        bf16* WIN_T = (bf16*)(X.ws + WS_WIN_T); bf16* WOUT_T = (bf16*)(X.ws + WS_WOUT_T); bf16* KV_T = (bf16*)(X.ws + WS_KV_T);
        bf16* WQ_T = (bf16*)(X.ws + WS_WQ_T); bf16* BWOUT_T = (bf16*)(X.ws + WS_BWOUT_T); bf16* UP_T = (bf16*)(X.ws + WS_UP_T); bf16* DOWN_T = (bf16*)(X.ws + WS_DOWN_T);
        constexpr int I0 = 16 * 128, I1 = 512, I2 = 16 * 8, I3 = 512, I4 = 512, I5 = 64 * 1024, I6 = 64 * 512;
        constexpr int NITEMS = I0 + I1 + I2 + I3 + I4 + I5 + I6;
        for (int it = X.gw; it < NITEMS; it += X.NGW) {
            int r = it;
            if (r < I0) { tr_item(a.in[6], 4112, 64 * (r / 128), 32 * (r % 128), WIN_T, 32 * (r % 128), scr, X.lane); continue; } r -= I0;
            if (r < I1) { tr_item(a.in[11], 1024, 64 * (r / 32), 32 * (r % 32), WOUT_T, 32 * (r % 32), scr, X.lane); continue; } r -= I1;
            if (r < I2) { tr_item(a.in[15], 256, 64 * (r / 8), 32 * (r % 8), KV_T, 32 * (r % 8), scr, X.lane); continue; } r -= I2;
            if (r < I3) { tr_item(a.in[17], 1024, 64 * (r / 32), 32 * (r % 32), WQ_T, 32 * (r % 32), scr, X.lane); continue; } r -= I3;
            if (r < I4) { tr_item(a.in[20], 1024, 64 * (r / 32), 32 * (r % 32), BWOUT_T, 32 * (r % 32), scr, X.lane); continue; } r -= I4;
            if (r < I5) { const int mi = r >> 10, rr = r & 1023, kb = rr >> 6, nb = rr & 63, n0 = 32 * nb, half = n0 >> 10, j0 = n0 & 1023;
                tr_item(a.in[23] + (size_t)mi * 1024 * 2048, 2048, 64 * kb, n0, UP_T + (size_t)mi * 2048 * 1024, (j0 >> 7) * 256 + half * 128 + (j0 & 127), scr, X.lane); continue; } r -= I5;
            { const int mi = r >> 9, rr = r & 511, kb = rr >> 5, nb = rr & 31;
                tr_item(a.in[25] + (size_t)mi * 1024 * 1024, 1024, 64 * kb, 32 * nb, DOWN_T + (size_t)mi * 1024 * 1024, 32 * nb, scr, X.lane); }
        }
    }
}

DI void load_affine(const float* gain, const float* scale, const float* shift, int lane, f32x4 (&A)[4], f32x4 (&Bv)[4]) {
#pragma unroll
    for (int j = 0; j < 4; ++j) { const int d = 4 * lane + 256 * j; const f32x4 g = *(const f32x4*)(gain + d), sc = *(const f32x4*)(scale + d); A[j] = g * (sc + 1.0f); Bv[j] = *(const f32x4*)(shift + d); }
}
DI void store_bf16_row(bf16* row, int lane, const f32x4 (&h)[4]) {
#pragma unroll
    for (int j = 0; j < 4; ++j) { u32x2 w; w.x = pk2(h[j][0], h[j][1]); w.y = pk2(h[j][2], h[j][3]); *(u32x2*)(row + 4 * lane + 256 * j) = w; }
}
DI float row_rs(const f32x4 (&v)[4]) {
    float ss = 0.f;
#pragma unroll
    for (int j = 0; j < 4; ++j) ss += (v[j][0] * v[j][0] + v[j][1] * v[j][1]) + (v[j][2] * v[j][2] + v[j][3] * v[j][3]);
    return rsqrtf(wave_sum(ss) * (1.0f / 1024.0f) + EPS);
}

template <int NCH8>
DI void skinny4(const f32x4 (&hv)[4][4], const LAS float* WTL, int lane, float (&res)[NCH8]) {
#pragma unroll
    for (int q = 0; q < NCH8; ++q) res[q] = 0.f;
#pragma unroll 1
    for (int oc = 0; oc < NCH8; ++oc) {
        float p[32];
#pragma unroll
        for (int o = 0; o < 8; ++o) { f32x4 w[4];
#pragma unroll
            for (int j = 0; j < 4; ++j) w[j] = *(const LAS f32x4*)(WTL + (oc * 8 + o) * 1024 + 4 * lane + 256 * j);
#pragma unroll
            for (int tt = 0; tt < 4; ++tt) { float s = 0.f;
#pragma unroll
                for (int j = 0; j < 4; ++j) s += (hv[tt][j][0] * w[j][0] + hv[tt][j][1] * w[j][1]) + (hv[tt][j][2] * w[j][2] + hv[tt][j][3] * w[j][3]);
                p[tt * 8 + o] = s; }
            }
        { const bool hi = (lane & 32) != 0;
#pragma unroll
          for (int i = 0; i < 16; ++i) { const float keep = hi ? p[16 + i] : p[i], send = hi ? p[i] : p[16 + i]; p[i] = keep + __shfl_xor(send, 32); } }
        { const bool hi = (lane & 16) != 0;
#pragma unroll
          for (int i = 0; i < 8; ++i) { const float keep = hi ? p[8 + i] : p[i], send = hi ? p[i] : p[8 + i]; p[i] = keep + __shfl_xor(send, 16); } }
        { const bool hi = (lane & 8) != 0;
#pragma unroll
          for (int i = 0; i < 4; ++i) { const float keep = hi ? p[4 + i] : p[i], send = hi ? p[i] : p[4 + i]; p[i] = keep + __shfl_xor(send, 8); } }
        { const bool hi = (lane & 4) != 0;
#pragma unroll
          for (int i = 0; i < 2; ++i) { const float keep = hi ? p[2 + i] : p[i], send = hi ? p[i] : p[2 + i]; p[i] = keep + __shfl_xor(send, 4); } }
        { const bool hi = (lane & 2) != 0; const float keep = hi ? p[1] : p[0], send = hi ? p[0] : p[1]; p[0] = keep + __shfl_xor(send, 2); }
        const float rsum = p[0] + __shfl_xor(p[0], 1);
#pragma unroll
        for (int q = 0; q < NCH8; ++q) res[q] = (q == oc) ? rsum : res[q];
    }
}

DI void p1_norm1(const Ctx& X, const Args& a) {
    LAS float* WTL = (LAS float*)X.lds;
    const float* w_in = a.in[6];
    for (int idx = X.tid; idx < 16384; idx += NTHR) { const int d = idx >> 4, o = idx & 15; WTL[o * 1024 + d] = w_in[(size_t)d * 4112 + 4096 + o]; }
    __syncthreads();
    const float* MOD = (const float*)(X.ws + WS_MOD); bf16* H = (bf16*)(X.ws + WS_H); float* AB = (float*)(X.ws + WS_AB);
    for (int tb = X.gw; tb < T / 4; tb += X.NGW) {
        const int t0 = tb * 4, b = t0 / SEQ;
        f32x4 A[4], Bv[4]; load_affine(a.in[5], MOD + (size_t)b * MODW + 1024, MOD + (size_t)b * MODW, X.lane, A, Bv);
        f32x4 hv[4][4];
#pragma unroll
        for (int tt = 0; tt < 4; ++tt) { const float* xr = a.in[0] + (size_t)(t0 + tt) * D;
#pragma unroll
            for (int j = 0; j < 4; ++j) hv[tt][j] = *(const f32x4*)(xr + 4 * X.lane + 256 * j); }
#pragma unroll
        for (int tt = 0; tt < 4; ++tt) { const float r = row_rs(hv[tt]);
#pragma unroll
            for (int j = 0; j < 4; ++j) hv[tt][j] = hv[tt][j] * r * A[j] + Bv[j];
            store_bf16_row(H + (size_t)(t0 + tt) * D, X.lane, hv[tt]); }
        float res[2]; skinny4<2>(hv, WTL, X.lane, res);
        if ((X.lane & 1) == 0) { float* ab = AB + (size_t)(t0 + (X.lane >> 4)) * 16 + ((X.lane >> 1) & 7); ab[0] = res[0]; ab[8] = res[1]; }
    }
}

DI void p_norm_router(const Ctx& X, const Args& a, int layer, const float* xin) {
    LAS float* WTL = (LAS float*)X.lds;
    LAS int* HIST = (LAS int*)(X.lds + TAB_OFF); LAS int* BASE = HIST + 32; LAS int* ASG = HIST + 64;
    const float* rw = a.in[21] + (size_t)layer * 1024 * 32; const float* rb = a.in[22] + layer * 32;
    for (int idx = X.tid; idx < 32768; idx += NTHR) { const int d = idx >> 5, o = idx & 31; WTL[o * 1024 + d] = rw[idx]; }
    const float* MOD = (const float*)(X.ws + WS_MOD) + layer * 6144; bf16* H = (bf16*)(X.ws + WS_H);
    float* RGATE = (float*)(X.ws + WS_RGATE); int* LIST = (int*)(X.ws + WS_LIST);
    unsigned* gcnt = (unsigned*)(X.ws + WS_CTL) + CW_CNT + 64 * layer;
    const float* gain = a.in[5] + (size_t)(layer * 2 + 1) * D;
    for (int tb = X.vcu; tb < T / 64; tb += X.G) {
        if (X.tid < 32) HIST[X.tid] = 0;
        __syncthreads();
        const int tw0 = tb * 64 + X.wave * 8, b = tw0 / SEQ;
        int ln0 = X.lane; asm volatile("" : "+v"(ln0));
#pragma unroll 1
        for (int grp = 0; grp < 2; ++grp) {
            int ln = ln0; asm volatile("" : "+v"(ln));
            const int myo = (ln >> 1) & 7;
            const int t0 = tw0 + grp * 4;
            f32x4 A[4], Bv[4]; load_affine(gain, MOD + (size_t)b * MODW + 4096, MOD + (size_t)b * MODW + 3072, ln, A, Bv);
            f32x4 hv[4][4];
#pragma unroll
            for (int tt = 0; tt < 4; ++tt) { const float* xr = xin + (size_t)(t0 + tt) * D;
#pragma unroll
                for (int j = 0; j < 4; ++j) hv[tt][j] = *(const f32x4*)(xr + 4 * ln + 256 * j); }
#pragma unroll
            for (int tt = 0; tt < 4; ++tt) { const float r = row_rs(hv[tt]);
#pragma unroll
                for (int j = 0; j < 4; ++j) hv[tt][j] = hv[tt][j] * r * A[j] + Bv[j];
                store_bf16_row(H + (size_t)(t0 + tt) * D, ln, hv[tt]); }
            float lgv[4]; skinny4<4>(hv, WTL, ln, lgv);
#pragma unroll
            for (int oc = 0; oc < 4; ++oc) lgv[oc] += rb[oc * 8 + myo];
            float tv[4]; int ti[4];
#pragma unroll
            for (int k = 0; k < 4; ++k) { float best = lgv[0]; int bi = myo;
#pragma unroll
                for (int oc = 1; oc < 4; ++oc) if (lgv[oc] > best) { best = lgv[oc]; bi = oc * 8 + myo; }
#pragma unroll
                for (int o = 1; o < 16; o <<= 1) { const float ov = __shfl_xor(best, o); const int oi = __shfl_xor(bi, o); if (ov > best || (ov == best && oi < bi)) { best = ov; bi = oi; } }
                tv[k] = best; ti[k] = bi;
#pragma unroll
                for (int oc = 0; oc < 4; ++oc) if (oc * 8 + myo == bi) lgv[oc] = -3.0e38f; }
            const float e1 = __expf(tv[1] - tv[0]), e2 = __expf(tv[2] - tv[0]), e3 = __expf(tv[3] - tv[0]); const float inv = 1.0f / (1.0f + e1 + e2 + e3);
            const int k = ln & 15, tl = grp * 4 + (ln >> 4);
            if (k < 4) { const int e = k == 0 ? ti[0] : k == 1 ? ti[1] : k == 2 ? ti[2] : ti[3];
                const float gt = (k == 0 ? 1.0f : k == 1 ? e1 : k == 2 ? e2 : e3) * inv;
                const int lr = atomicAdd((int*)&HIST[e], 1);
                ASG[(X.wave * 8 + tl) * 4 + k] = (e << 16) | lr; RGATE[(size_t)(tw0 + tl) * 4 + k] = gt; }
        }
        __syncthreads();
        if (X.tid < 32) BASE[X.tid] = (int)__hip_atomic_fetch_add(gcnt + X.tid, (unsigned)HIST[X.tid], __ATOMIC_RELAXED, __HIP_MEMORY_SCOPE_AGENT);
        __syncthreads();
        if (X.tid < 256) { const int av = ASG[X.tid], e = av >> 16, lr = av & 0xffff; LIST[e * LISTCAP + BASE[e] + lr] = tb * 256 + X.tid; }
        __syncthreads();
    }
}

DI void moe_table(const Ctx& X, int layer) {
    LAS int* tab = (LAS int*)(X.lds + TAB_OFF);
    const unsigned* gcnt = (const unsigned*)(X.ws + WS_CTL) + CW_CNT + 64 * layer;
    if (X.tid < 32) tab[X.tid] = (int)__hip_atomic_load(gcnt + X.tid, __ATOMIC_RELAXED, __HIP_MEMORY_SCOPE_AGENT);
    __syncthreads();
    if (X.tid == 0) { int s = 0; for (int e = 0; e < 32; ++e) { tab[32 + e] = s; s += (tab[e] + 255) >> 8; } tab[64] = s; }
    __syncthreads();
    if (X.tid < 32) { const int s0 = tab[32 + X.tid], s1 = tab[33 + X.tid]; for (int q = s0; q < s1; ++q) tab[80 + q] = X.tid; }
    __syncthreads();
}

DI void p10_combine_norm(const Ctx& X, const Args& a) {
    const float* MOD = (const float*)(X.ws + WS_MOD); const float* X1 = (const float*)(X.ws + WS_X1); float* X2 = (float*)(X.ws + WS_X2);
    const bf16* YS = (const bf16*)(X.ws + WS_YS); const float* RGATE = (const float*)(X.ws + WS_RGATE);
    bf16* HKV = (bf16*)(X.ws + WS_HKV); bf16* HQ = (bf16*)(X.ws + WS_HQ);
    for (int tb = X.gw; tb < T / 8; tb += X.NGW) {
        const int t0 = tb * 8, b = t0 / SEQ; const float* mb = MOD + (size_t)b * MODW;
        f32x4 G2[4], Ak[4], Bk[4], Aq[4], Bq[4];
#pragma unroll
        for (int j = 0; j < 4; ++j) G2[j] = *(const f32x4*)(mb + 5120 + 4 * X.lane + 256 * j);
        load_affine(a.in[14], mb + 12288 + 1024, mb + 12288, X.lane, Ak, Bk);
        load_affine(a.in[5] + 2 * D, mb + 6144 + 1024, mb + 6144, X.lane, Aq, Bq);
        for (int tp = 0; tp < 8; tp += 2) {
            f32x4 gt[2], xv[2][4]; u32x2 yw[2][4][4];
#pragma unroll
            for (int q = 0; q < 2; ++q) { const int t = t0 + tp + q; gt[q] = *(const f32x4*)(RGATE + (size_t)t * 4);
#pragma unroll
                for (int j = 0; j < 4; ++j) { const int d = 4 * X.lane + 256 * j; xv[q][j] = *(const f32x4*)(X1 + (size_t)t * D + d);
#pragma unroll
                    for (int k = 0; k < 4; ++k) yw[q][j][k] = *(const u32x2*)(YS + ((size_t)t * 4 + k) * 1024 + d); } }
#pragma unroll
            for (int q = 0; q < 2; ++q) { const int t = t0 + tp + q;
                f32x4 v[4];
#pragma unroll
                for (int j = 0; j < 4; ++j) { const int d = 4 * X.lane + 256 * j; f32x4 s = (f32x4){0.f, 0.f, 0.f, 0.f};
#pragma unroll
                    for (int k = 0; k < 4; ++k) { const u32x2 w = yw[q][j][k]; const float g = gt[q][k];
                        s[0] += g * bflo(w.x); s[1] += g * bfhi(w.x); s[2] += g * bflo(w.y); s[3] += g * bfhi(w.y); }
                    v[j] = xv[q][j] + G2[j] * s; *(f32x4*)(X2 + (size_t)t * D + d) = v[j]; }
                const float r = row_rs(v);
                f32x4 h[4];
#pragma unroll
                for (int j = 0; j < 4; ++j) h[j] = v[j] * r * Ak[j] + Bk[j];
                store_bf16_row(HKV + (size_t)t * D, X.lane, h);
#pragma unroll
                for (int j = 0; j < 4; ++j) h[j] = v[j] * r * Aq[j] + Bq[j];
                store_bf16_row(HQ + (size_t)t * D, X.lane, h); }
        }
    }
}
DI void p18_final(const Ctx& X, const Args& a) {
    const float* MOD = (const float*)(X.ws + WS_MOD); const float* X3 = (const float*)(X.ws + WS_X1);
    const bf16* YS = (const bf16*)(X.ws + WS_YS); const float* RGATE = (const float*)(X.ws + WS_RGATE);
    for (int tb = X.gw; tb < T / 8; tb += X.NGW) {
        const int t0 = tb * 8, b = t0 / SEQ; const float* mb = MOD + (size_t)b * MODW + 6144;
        f32x4 G2[4];
#pragma unroll
        for (int j = 0; j < 4; ++j) G2[j] = *(const f32x4*)(mb + 5120 + 4 * X.lane + 256 * j);
        for (int tp = 0; tp < 8; tp += 2) {
            f32x4 gt[2], xv[2][4]; u32x2 yw[2][4][4];
#pragma unroll
            for (int q = 0; q < 2; ++q) { const int t = t0 + tp + q; gt[q] = *(const f32x4*)(RGATE + (size_t)t * 4);
#pragma unroll
                for (int j = 0; j < 4; ++j) { const int d = 4 * X.lane + 256 * j; xv[q][j] = *(const f32x4*)(X3 + (size_t)t * D + d);
#pragma unroll
                    for (int k = 0; k < 4; ++k) yw[q][j][k] = *(const u32x2*)(YS + ((size_t)t * 4 + k) * 1024 + d); } }
#pragma unroll
            for (int q = 0; q < 2; ++q) { const int t = t0 + tp + q;
#pragma unroll
                for (int j = 0; j < 4; ++j) { const int d = 4 * X.lane + 256 * j; f32x4 s = (f32x4){0.f, 0.f, 0.f, 0.f};
#pragma unroll
                    for (int k = 0; k < 4; ++k) { const u32x2 w = yw[q][j][k]; const float g = gt[q][k];
                        s[0] += g * bflo(w.x); s[1] += g * bfhi(w.x); s[2] += g * bflo(w.y); s[3] += g * bfhi(w.y); }
                    *(f32x4*)(a.out + (size_t)t * D + d) = xv[q][j] + G2[j] * s; } }
        }
    }
}

DI void unpack16(const u32x4 a, const u32x4 b, float (&f)[16]) {
    f[0] = bflo(a.x); f[1] = bfhi(a.x); f[2] = bflo(a.y); f[3] = bfhi(a.y); f[4] = bflo(a.z); f[5] = bfhi(a.z); f[6] = bflo(a.w); f[7] = bfhi(a.w);
    f[8] = bflo(b.x); f[9] = bfhi(b.x); f[10] = bflo(b.y); f[11] = bfhi(b.y); f[12] = bflo(b.z); f[13] = bfhi(b.z); f[14] = bflo(b.w); f[15] = bfhi(b.w);
}
DI void store16(bf16* p, const float (&f)[16]) {
    u32x4 a, b; a.x = pk2(f[0], f[1]); a.y = pk2(f[2], f[3]); a.z = pk2(f[4], f[5]); a.w = pk2(f[6], f[7]); b.x = pk2(f[8], f[9]); b.y = pk2(f[10], f[11]); b.z = pk2(f[12], f[13]); b.w = pk2(f[14], f[15]);
    *(u32x4*)p = a; *(u32x4*)(p + 8) = b;
}
DI void p5_onorm(const Ctx& X, const Args& a) {
    const bf16* O = (const bf16*)(X.ws + WS_O); const bf16* PROJ = (const bf16*)(X.ws + WS_PROJ); bf16* ON = (bf16*)(X.ws + WS_ON);
    float og[16];
#pragma unroll
    for (int i = 0; i < 16; ++i) og[i] = a.in[10][(16 * X.lane + i) & 127];
    for (int tb = X.gw; tb < T / 4; tb += X.NGW) {
        u32x4 ov[4][2], zv[4][2];
#pragma unroll
        for (int tt = 0; tt < 4; ++tt) { const size_t t = (size_t)tb * 4 + tt;
            ov[tt][0] = *(const u32x4*)(O + t * D + 16 * X.lane); ov[tt][1] = *(const u32x4*)(O + t * D + 16 * X.lane + 8);
            zv[tt][0] = *(const u32x4*)(PROJ + t * 4096 + 3072 + 16 * X.lane); zv[tt][1] = *(const u32x4*)(PROJ + t * 4096 + 3072 + 16 * X.lane + 8); }
#pragma unroll
        for (int tt = 0; tt < 4; ++tt) { const size_t t = (size_t)tb * 4 + tt;
            float o[16], z[16]; unpack16(ov[tt][0], ov[tt][1], o); unpack16(zv[tt][0], zv[tt][1], z);
            float ss = 0.f;
#pragma unroll
            for (int i = 0; i < 16; ++i) ss += o[i] * o[i];
            ss += __shfl_xor(ss, 1); ss += __shfl_xor(ss, 2); ss += __shfl_xor(ss, 4);
            const float r = rsqrtf(ss * (1.0f / 128.0f) + EPS);
#pragma unroll
            for (int i = 0; i < 16; ++i) o[i] = o[i] * r * og[i] * siluf_(z[i]);
            store16(ON + t * D + 16 * X.lane, o); }
    }
}

DI void p12_qknorm(const Ctx& X, const Args& a) {
    const bf16* QKV = (const bf16*)(X.ws + WS_QKV); const float* ROPE = (const float*)(X.ws + WS_ROPE);
    bf16* QN = (bf16*)(X.ws + WS_QN); bf16* KN = (bf16*)(X.ws + WS_KN); bf16* VT = (bf16*)(X.ws + WS_VT);
    float qg[16], kg[16];
#pragma unroll
    for (int i = 0; i < 16; ++i) { qg[i] = a.in[18][(16 * X.lane + i) & 63]; kg[i] = a.in[16][(16 * X.lane + i) & 63]; }
    for (int t = X.gw; t < T; t += X.NGW) {
        const int b = t / SEQ, s = t % SEQ;
        float cs[8], sn[8];
        { const f32x4 c0 = *(const f32x4*)(ROPE + (size_t)t * 16), c1 = *(const f32x4*)(ROPE + (size_t)t * 16 + 4), s0 = *(const f32x4*)(ROPE + (size_t)t * 16 + 8), s1 = *(const f32x4*)(ROPE + (size_t)t * 16 + 12);
#pragma unroll
          for (int i = 0; i < 4; ++i) { cs[i] = c0[i]; cs[4 + i] = c1[i]; sn[i] = s0[i]; sn[4 + i] = s1[i]; } }
        float q[16];
        unpack16(*(const u32x4*)(QKV + (size_t)t * 1280 + 256 + 16 * X.lane), *(const u32x4*)(QKV + (size_t)t * 1280 + 256 + 16 * X.lane + 8), q);
        float ss = 0.f;
#pragma unroll
        for (int i = 0; i < 16; ++i) ss += q[i] * q[i];
        ss += __shfl_xor(ss, 1); ss += __shfl_xor(ss, 2);
        float r = rsqrtf(ss * (1.0f / 64.0f) + EPS);
#pragma unroll
        for (int i = 0; i < 16; ++i) q[i] = q[i] * r * qg[i];
        if ((X.lane & 3) == 0) {
#pragma unroll
            for (int i = 0; i < 8; ++i) { const float x1 = q[i], x2 = q[8 + i]; q[i] = x1 * cs[i] - x2 * sn[i]; q[8 + i] = x2 * cs[i] + x1 * sn[i]; } }
#pragma unroll
        for (int i = 0; i < 16; ++i) q[i] *= 0.125f;
        store16(QN + (size_t)t * D + 16 * X.lane, q);
        if (X.lane < 8) {
            float k[16], v[16];
            unpack16(*(const u32x4*)(QKV + (size_t)t * 1280 + 16 * X.lane), *(const u32x4*)(QKV + (size_t)t * 1280 + 16 * X.lane + 8), k);
            unpack16(*(const u32x4*)(QKV + (size_t)t * 1280 + 128 + 16 * X.lane), *(const u32x4*)(QKV + (size_t)t * 1280 + 128 + 16 * X.lane + 8), v);
            float s2 = 0.f;
#pragma unroll
            for (int i = 0; i < 16; ++i) s2 += k[i] * k[i];
            s2 += __shfl_xor(s2, 1); s2 += __shfl_xor(s2, 2);
            r = rsqrtf(s2 * (1.0f / 64.0f) + EPS);
#pragma unroll
            for (int i = 0; i < 16; ++i) k[i] = k[i] * r * kg[i];
            if ((X.lane & 3) == 0) {
#pragma unroll
                for (int i = 0; i < 8; ++i) { const float x1 = k[i], x2 = k[8 + i]; k[i] = x1 * cs[i] - x2 * sn[i]; k[8 + i] = x2 * cs[i] + x1 * sn[i]; } }
            const int kvh = X.lane >> 2, d0 = (16 * X.lane) & 63;
            store16(KN + ((size_t)(b * 2 + kvh) * SEQ + s) * 64 + d0, k);
#pragma unroll
            for (int i = 0; i < 16; ++i) VT[((size_t)(b * 2 + kvh) * 64 + d0 + i) * SEQ + s] = (bf16)f2bf(v[i]);
        }
    }
}

#define MFMA4F(a, b, c) __builtin_amdgcn_mfma_f32_16x16x4f32((a), (b), (c), 0, 0, 0)
constexpr int P3_QB = 0, P3_KB = 17408, P3_RT = 34816, P3_AF = 71680, P3_TF = 89088, P3_WS = 106496, P3_TB = 123904, P3_GC = 133120;
DI f32x4 blk_mm(f32x4 acc, const LAS float* Xm, int xr0, int xc0, const LAS float* Ym, int yr0, int yc0, int fr, int fq) {
#pragma unroll
    for (int s = 0; s < 4; ++s) acc = MFMA4F(Xm[(xr0 + fr) * 68 + xc0 + 4 * s + fq], Ym[(yr0 + 4 * s + fq) * 68 + yc0 + fr], acc);
    return acc;
}
DI void blk_st(LAS float* M, int r0, int c0, const f32x4 acc, float sgn, int fr, int fq) {
#pragma unroll
    for (int r = 0; r < 4; ++r) M[(r0 + 4 * fq + r) * 68 + c0 + fr] = sgn * acc[r];
}
DI void blk_st_tb(LAS float* TF, LAS bf16* TB, int r0, int c0, const f32x4 acc, int fr, int fq) {
#pragma unroll
    for (int r = 0; r < 4; ++r) { TF[(r0 + 4 * fq + r) * 68 + c0 + fr] = -acc[r]; TB[(r0 + 4 * fq + r) * 72 + c0 + fr] = (bf16)f2bf(-acc[r]); }
}
DI u32x4 pack8(const float (&f)[8]) { u32x4 w; w.x = pk2(f[0], f[1]); w.y = pk2(f[2], f[3]); w.z = pk2(f[4], f[5]); w.w = pk2(f[6], f[7]); return w; }
DI void p3_prep(const Ctx& X, const Args& a) {
    LAS bf16* QB = (LAS bf16*)(X.lds + P3_QB); LAS bf16* KBb = (LAS bf16*)(X.lds + P3_KB); LAS bf16* RT = (LAS bf16*)(X.lds + P3_RT);
    LAS float* AF = (LAS float*)(X.lds + P3_AF); LAS float* TF = (LAS float*)(X.lds + P3_TF); LAS float* WSm = (LAS float*)(X.lds + P3_WS);
    LAS bf16* TB = (LAS bf16*)(X.lds + P3_TB);
    LAS float* GC = (LAS float*)(X.lds + P3_GC); LAS float* BETA = GC + 64; LAS float* EG = GC + 128;
    const bf16* PROJ = (const bf16*)(X.ws + WS_PROJ); const float* AB = (const float*)(X.ws + WS_AB);
    float* UT = (float*)(X.ws + WS_UT); bf16* WNEG = (bf16*)(X.ws + WS_WNEG); bf16* QD = (bf16*)(X.ws + WS_QD); bf16* KTT = (bf16*)(X.ws + WS_KTT); bf16* QKG = (bf16*)(X.ws + WS_QK);
    float* GTOT = (float*)(X.ws + WS_GTOT);
    const float* convw = a.in[7];
    const int fr_ = X.lane & 15, fq_ = X.lane >> 4;
    for (int idx = X.tid; idx < 64 * 72 / 2; idx += NTHR) ((LAS unsigned*)TB)[idx] = 0u;
    BAR_LDS();
    u32x4 xr[11]; f32x4 cw[4][2]; float avn = 0.f, bvn = 0.f;
#define P3_LOAD(cid_) do { const int c_ = (cid_); const int b_ = c_ >> 8, h_ = (c_ >> 5) & 7, n_ = c_ & 31, t0_ = b_ * SEQ + n_ * 64; \
        int fr__ = fr_, fq__ = fq_; asm volatile("" : "+v"(fr__), "+v"(fq__)); \
        if (X.wave < 6) { const int which_ = X.wave >> 1, rs_ = (X.wave & 1) * 4 + fq__, ch0_ = which_ * 1024 + h_ * 128 + 8 * fr__; \
            const bf16* src_ = PROJ + ((ptrdiff_t)t0_ + 8 * rs_ - 3) * 4096 + ch0_; \
            _Pragma("unroll") for (int m = 0; m < 11; ++m) { const bool valid_ = (n_ > 0) || (8 * rs_ - 3 + m >= 0); xr[m] = (u32x4){0u, 0u, 0u, 0u}; if (valid_) xr[m] = *(const u32x4*)(src_ + (ptrdiff_t)m * 4096); } \
            _Pragma("unroll") for (int i = 0; i < 4; ++i) { cw[i][0] = *(const f32x4*)(convw + i * 3072 + ch0_); cw[i][1] = *(const f32x4*)(convw + i * 3072 + ch0_ + 4); } \
        } else if (X.wave == 6) { const int i_ = fq__ * 16 + fr__; avn = AB[(size_t)(t0_ + i_) * 16 + h_]; bvn = AB[(size_t)(t0_ + i_) * 16 + 8 + h_]; } } while (0)
    if (X.vcu < NB * AH * NCH) P3_LOAD(X.vcu);
    for (int cid = X.vcu; cid < NB * AH * NCH; cid += X.G) {
        int fr = fr_, fq = fq_; asm volatile("" : "+v"(fr), "+v"(fq));
        const int b = cid >> 8, h = (cid >> 5) & 7, n = cid & 31, t0 = b * SEQ + n * 64;
        const size_t rowbase = (size_t)(b * 8 + h) * SEQ + n * 64;
        const int which = X.wave >> 1, rs = (X.wave & 1) * 4 + fq, cg = fr;
        if (X.wave == 6) {
            const int i = fq * 16 + fr;
            const float xx = avn + a.in[9][h]; const float sp = xx > 20.f ? xx : log1pf(__expf(xx));
            float g = -__expf(a.in[8][h]) * sp;
#pragma unroll
            for (int o = 1; o < 64; o <<= 1) { const float up = __shfl_up(g, o); if (i >= o) g += up; }
            GC[i] = g; BETA[i] = sigmoidf_(bvn); EG[i] = __expf(g);
            if (i == 63) GTOT[cid] = __expf(g);
        }
        BAR_LDS();
        if (X.wave < 6) {
            float y[8][8];
#pragma unroll
            for (int ch = 0; ch < 8; ++ch) { float xc[11];
#pragma unroll
                for (int m = 0; m < 11; ++m) { const unsigned wv = xr[m][ch >> 1]; xc[m] = (ch & 1) ? bfhi(wv) : bflo(wv); }
                const float w0 = cw[0][ch >> 2][ch & 3], w1 = cw[1][ch >> 2][ch & 3], w2 = cw[2][ch >> 2][ch & 3], w3 = cw[3][ch >> 2][ch & 3];
#pragma unroll
                for (int rr = 0; rr < 8; ++rr) y[rr][ch] = siluf_(w0 * xc[rr] + w1 * xc[rr + 1] + w2 * xc[rr + 2] + w3 * xc[rr + 3]); }
            float be[8], eg[8], gcr[8];
#pragma unroll
            for (int rr = 0; rr < 8; ++rr) { be[rr] = BETA[8 * rs + rr]; eg[rr] = EG[8 * rs + rr]; gcr[rr] = GC[8 * rs + rr]; }
            if (which < 2) {
#pragma unroll
                for (int rr = 0; rr < 8; ++rr) { float ss = 0.f;
#pragma unroll
                    for (int ch = 0; ch < 8; ++ch) ss += y[rr][ch] * y[rr][ch];
                    ss += __shfl_xor(ss, 1); ss += __shfl_xor(ss, 2); ss += __shfl_xor(ss, 4); ss += __shfl_xor(ss, 8);
                    const float r = rsqrtf(ss + EPS) * (which == 0 ? 0.08838834764831845f : 1.0f);
#pragma unroll
                    for (int ch = 0; ch < 8; ++ch) y[rr][ch] *= r; }
            }
            if (which == 0) {
#pragma unroll
                for (int rr = 0; rr < 8; ++rr) { *(LAS u32x4*)(QB + (8 * rs + rr) * 136 + 8 * cg) = pack8(y[rr]);
                    float s[8];
#pragma unroll
                    for (int ch = 0; ch < 8; ++ch) s[ch] = y[rr][ch] * eg[rr];
                    *(u32x4*)(QD + (rowbase + 8 * rs + rr) * 128 + 8 * cg) = pack8(s); }
            } else if (which == 1) {
                const float gl = GC[63];
                float tail[8];
#pragma unroll
                for (int rr = 0; rr < 8; ++rr) { *(LAS u32x4*)(KBb + (8 * rs + rr) * 136 + 8 * cg) = pack8(y[rr]); tail[rr] = __expf(gl - gcr[rr]); }
#pragma unroll
                for (int ch = 0; ch < 8; ++ch) { float s[8], u[8];
#pragma unroll
                    for (int rr = 0; rr < 8; ++rr) { s[rr] = y[rr][ch] * be[rr] * eg[rr]; u[rr] = y[rr][ch] * tail[rr]; }
                    *(LAS u32x4*)(RT + (128 + 8 * cg + ch) * 72 + 8 * rs) = pack8(s);
                    *(u32x4*)(KTT + (size_t)cid * 8192 + (8 * cg + ch) * 64 + 8 * rs) = pack8(u); }
            } else {
#pragma unroll
                for (int ch = 0; ch < 8; ++ch) { float s[8];
#pragma unroll
                    for (int rr = 0; rr < 8; ++rr) s[rr] = y[rr][ch] * be[rr];
                    *(LAS u32x4*)(RT + (8 * cg + ch) * 72 + 8 * rs) = pack8(s); }
            }
        }
        if (cid + X.G < NB * AH * NCH) P3_LOAD(cid + X.G);
        BAR_LDS();
        if (X.wave == 0) {
#pragma unroll
            for (int ab = 0; ab < 10; ++ab) { const int ta = ab < 1 ? 0 : ab < 3 ? 1 : ab < 6 ? 2 : 3, tb = ab - (ta * (ta + 1)) / 2;
                f32x4 acc = (f32x4){0.f, 0.f, 0.f, 0.f};
#pragma unroll
                for (int kk = 0; kk < 4; ++kk) acc = MFMA16(*(const LAS bf16x8*)(KBb + (16 * ta + fr) * 136 + kk * 32 + fq * 8), *(const LAS bf16x8*)(KBb + (16 * tb + fr) * 136 + kk * 32 + fq * 8), acc);
                const int j = 16 * tb + fr; const float gj = GC[j];
#pragma unroll
                for (int r = 0; r < 4; ++r) { const int i = 16 * ta + 4 * fq + r; AF[i * 68 + j] = (i > j) ? acc[r] * BETA[i] * __expf(fminf(GC[i] - gj, 0.f)) : 0.f; } }
            asm volatile("s_waitcnt lgkmcnt(0)" ::: "memory");
            {
                const int kb = fq, c = fr; float t[16];
#pragma unroll
                for (int ii = 0; ii < 16; ++ii) { const LAS float* ar = AF + (16 * kb + ii) * 68 + 16 * kb;
                    float av[16];
#pragma unroll
                    for (int q = 0; q < 4; ++q) { const f32x4 v4 = *(const LAS f32x4*)(ar + 4 * q); av[4 * q] = v4[0]; av[4 * q + 1] = v4[1]; av[4 * q + 2] = v4[2]; av[4 * q + 3] = v4[3]; }
                    float s = (ii == c) ? 1.f : 0.f;
#pragma unroll
                    for (int jj = 0; jj < ii; ++jj) s -= av[jj] * t[jj];
                    t[ii] = s; }
#pragma unroll
                for (int ii = 0; ii < 16; ++ii) { TF[(16 * kb + ii) * 68 + 16 * kb + c] = t[ii]; TB[(16 * kb + ii) * 72 + 16 * kb + c] = (bf16)f2bf(t[ii]); }
            }
            asm volatile("s_waitcnt lgkmcnt(0)" ::: "memory");
            const f32x4 z4 = (f32x4){0.f, 0.f, 0.f, 0.f};
            { const f32x4 w10 = blk_mm(z4, AF, 16, 0, TF, 0, 0, fr, fq), w32 = blk_mm(z4, AF, 48, 32, TF, 32, 32, fr, fq);
              blk_st(WSm, 16, 0, w10, 1.f, fr, fq); blk_st(WSm, 48, 32, w32, 1.f, fr, fq); }
            asm volatile("s_waitcnt lgkmcnt(0)" ::: "memory");
            { const f32x4 t10 = blk_mm(z4, TF, 16, 16, WSm, 16, 0, fr, fq), t32 = blk_mm(z4, TF, 48, 48, WSm, 48, 32, fr, fq);
              blk_st_tb(TF, TB, 16, 0, t10, fr, fq); blk_st_tb(TF, TB, 48, 32, t32, fr, fq); }
            asm volatile("s_waitcnt lgkmcnt(0)" ::: "memory");
            { f32x4 w20 = blk_mm(z4, AF, 32, 0, TF, 0, 0, fr, fq); w20 = blk_mm(w20, AF, 32, 16, TF, 16, 0, fr, fq);
              f32x4 w30 = blk_mm(z4, AF, 48, 0, TF, 0, 0, fr, fq); w30 = blk_mm(w30, AF, 48, 16, TF, 16, 0, fr, fq);
              const f32x4 w21 = blk_mm(z4, AF, 32, 16, TF, 16, 16, fr, fq), w31 = blk_mm(z4, AF, 48, 16, TF, 16, 16, fr, fq);
              blk_st(WSm, 32, 0, w20, 1.f, fr, fq); blk_st(WSm, 48, 0, w30, 1.f, fr, fq); blk_st(WSm, 32, 16, w21, 1.f, fr, fq); blk_st(WSm, 48, 16, w31, 1.f, fr, fq); }
            asm volatile("s_waitcnt lgkmcnt(0)" ::: "memory");
            { const f32x4 t20 = blk_mm(z4, TF, 32, 32, WSm, 32, 0, fr, fq), t21 = blk_mm(z4, TF, 32, 32, WSm, 32, 16, fr, fq);
              f32x4 t30 = blk_mm(z4, TF, 48, 32, WSm, 32, 0, fr, fq); t30 = blk_mm(t30, TF, 48, 48, WSm, 48, 0, fr, fq);
              f32x4 t31 = blk_mm(z4, TF, 48, 32, WSm, 32, 16, fr, fq); t31 = blk_mm(t31, TF, 48, 48, WSm, 48, 16, fr, fq);
              blk_st_tb(TF, TB, 32, 0, t20, fr, fq); blk_st_tb(TF, TB, 32, 16, t21, fr, fq); blk_st_tb(TF, TB, 48, 0, t30, fr, fq); blk_st_tb(TF, TB, 48, 16, t31, fr, fq); }
        } else {
            for (int tt = X.wave - 1; tt < 16; tt += 7) { const int it = tt >> 2, jt = tt & 3;
                f32x4 acc = (f32x4){0.f, 0.f, 0.f, 0.f};
                if (it >= jt) {
#pragma unroll
                    for (int kk = 0; kk < 4; ++kk) acc = MFMA16(*(const LAS bf16x8*)(KBb + (16 * jt + fr) * 136 + kk * 32 + fq * 8), *(const LAS bf16x8*)(QB + (16 * it + fr) * 136 + kk * 32 + fq * 8), acc);
                }
                const int i = 16 * it + fr; const float gi = GC[i]; float v[4];
#pragma unroll
                for (int r = 0; r < 4; ++r) { const int j = 16 * jt + 4 * fq + r; v[r] = (j <= i) ? acc[r] * __expf(fminf(gi - GC[j], 0.f)) : 0.f; }
                u32x2 p; p.x = pk2(v[0], v[1]); p.y = pk2(v[2], v[3]);
                *(u32x2*)(QKG + (size_t)cid * 4096 + i * 64 + 16 * jt + 4 * fq) = p; }
        }
        BAR_LDS();
        {
            const int half = X.wave >> 2, it = X.wave & 3, ns = it < 2 ? 1 : 2;
            bf16x8 tf[2];
#pragma unroll
            for (int s = 0; s < 2; ++s) tf[s] = *(const LAS bf16x8*)(TB + (16 * it + fr) * 72 + 32 * (s < ns ? s : 0) + 8 * fq);
#pragma unroll
            for (int ct = 0; ct < 8; ++ct) { const int c0 = half * 128 + 16 * ct;
                f32x4 acc = (f32x4){0.f, 0.f, 0.f, 0.f};
                if (half == 0) {
#pragma unroll
                    for (int s = 0; s < 2; ++s) if (s < ns) acc = MFMA16(tf[s], *(const LAS bf16x8*)(RT + (c0 + fr) * 72 + 32 * s + 8 * fq), acc);
                    *(f32x4*)(UT + (size_t)cid * 8192 + (c0 + fr) * 64 + 16 * it + 4 * fq) = acc;
                } else {
#pragma unroll
                    for (int s = 0; s < 2; ++s) if (s < ns) acc = MFMA16(*(const LAS bf16x8*)(RT + (c0 + fr) * 72 + 32 * s + 8 * fq), tf[s], acc);
                    u32x2 p; p.x = pk2(-acc[0], -acc[1]); p.y = pk2(-acc[2], -acc[3]);
                    *(u32x2*)(WNEG + (rowbase + 16 * it + fr) * 128 + (c0 - 128) + 4 * fq) = p; }
            }
        }
        BAR_LDS();
    }
#undef P3_LOAD
}

struct ScanFrag { bf16x8 wn[4], qd[4], qk[2], kt[2]; f32x4 u; float gt; };
DI ScanFrag scan_load(const float* UT, const bf16* WNEG, const bf16* QD, const bf16* KTT, const bf16* QKG, const float* GTOT, int bh, int n, int sl, int w, int et, int jt, int fr, int fq) {
    ScanFrag f; const int cid = bh * 32 + n; const size_t rowbase = (size_t)bh * SEQ + n * 64;
#pragma unroll
    for (int kk = 0; kk < 4; ++kk) { f.wn[kk] = *(const bf16x8*)(WNEG + (rowbase + 16 * jt + fr) * 128 + kk * 32 + fq * 8); f.qd[kk] = *(const bf16x8*)(QD + (rowbase + 16 * jt + fr) * 128 + kk * 32 + fq * 8); }
#pragma unroll
    for (int k2 = 0; k2 < 2; ++k2) { f.qk[k2] = *(const bf16x8*)(QKG + (size_t)cid * 4096 + (16 * jt + fr) * 64 + k2 * 32 + fq * 8); f.kt[k2] = *(const bf16x8*)(KTT + (size_t)cid * 8192 + (16 * w + fr) * 64 + k2 * 32 + fq * 8); }
    f.u = *(const f32x4*)(UT + (size_t)cid * 8192 + (sl * 32 + 16 * et + fr) * 64 + 16 * jt + 4 * fq);
    f.gt = GTOT[cid];
    return f;
}
DI void scan_step(const ScanFrag& cur, f32x4& S0, f32x4& S1, LAS bf16* SL, LAS bf16* VL, bf16* orow, int w, int et, int jt, int fr, int fq) {
    f32x4 v = cur.u;
    { u32x2 p0, p1; p0.x = pk2(S0[0], S0[1]); p0.y = pk2(S0[2], S0[3]); p1.x = pk2(S1[0], S1[1]); p1.y = pk2(S1[2], S1[3]);
      *(LAS u32x2*)(SL + fr * 136 + 16 * w + 4 * fq) = p0; *(LAS u32x2*)(SL + (16 + fr) * 136 + 16 * w + 4 * fq) = p1; }
    BAR_LDS();
    f32x4 o = (f32x4){0.f, 0.f, 0.f, 0.f};
#pragma unroll
    for (int kk = 0; kk < 4; ++kk) { const bf16x8 sf = *(const LAS bf16x8*)(SL + (16 * et + fr) * 136 + kk * 32 + fq * 8);
        v = MFMA16(cur.wn[kk], sf, v); o = MFMA16(sf, cur.qd[kk], o); }
    { u32x2 p; p.x = pk2(v[0], v[1]); p.y = pk2(v[2], v[3]); *(LAS u32x2*)(VL + (16 * et + fr) * 72 + 16 * jt + 4 * fq) = p; }
    BAR_LDS();
#pragma unroll
    for (int r = 0; r < 4; ++r) { S0[r] *= cur.gt; S1[r] *= cur.gt; }
#pragma unroll
    for (int k2 = 0; k2 < 2; ++k2) { const bf16x8 v0 = *(const LAS bf16x8*)(VL + fr * 72 + k2 * 32 + fq * 8), v1 = *(const LAS bf16x8*)(VL + (16 + fr) * 72 + k2 * 32 + fq * 8);
        o = MFMA16(et ? v1 : v0, cur.qk[k2], o); S0 = MFMA16(cur.kt[k2], v0, S0); S1 = MFMA16(cur.kt[k2], v1, S1); }
    { u32x2 p; p.x = pk2(o[0], o[1]); p.y = pk2(o[2], o[3]); *(u32x2*)orow = p; }
}
DI void p4_scan(const Ctx& X, const Args& a) {
    LAS bf16* SL = (LAS bf16*)X.lds;
    LAS bf16* VL = (LAS bf16*)(X.lds + 32 * 136 * 2);
    const float* UT = (const float*)(X.ws + WS_UT); const bf16* WNEG = (const bf16*)(X.ws + WS_WNEG); const bf16* QD = (const bf16*)(X.ws + WS_QD);
    const bf16* KTT = (const bf16*)(X.ws + WS_KTT); const bf16* QKG = (const bf16*)(X.ws + WS_QK); const float* GTOT = (const float*)(X.ws + WS_GTOT);
    bf16* O = (bf16*)(X.ws + WS_O);
    const int fr = X.lane & 15, fq = X.lane >> 4, w = X.wave, et = w & 1, jt = w >> 1;
    for (int unit = X.vcu; unit < NB * AH * 4; unit += X.G) {
        const int bh = unit >> 2, sl = unit & 3, b = bh >> 3, h = bh & 7;
        f32x4 S0 = (f32x4){0.f, 0.f, 0.f, 0.f}, S1 = S0;
        bf16* obase = O + (size_t)(b * SEQ + 16 * jt + fr) * D + h * 128 + sl * 32 + 16 * et + 4 * fq;
#define SCAN_LOAD(n_) scan_load(UT, WNEG, QD, KTT, QKG, GTOT, bh, (n_) < NCH ? (n_) : NCH - 1, sl, w, et, jt, fr, fq)
        ScanFrag fa = SCAN_LOAD(0), fb = SCAN_LOAD(1), fc;
        for (int n = 0; n < NCH; n += 3) {
            fc = SCAN_LOAD(n + 2); scan_step(fa, S0, S1, SL, VL, obase + (size_t)n * 64 * D, w, et, jt, fr, fq);
            if (n + 1 >= NCH) break;
            fa = SCAN_LOAD(n + 3); scan_step(fb, S0, S1, SL, VL, obase + (size_t)(n + 1) * 64 * D, w, et, jt, fr, fq);
            if (n + 2 >= NCH) break;
            fb = SCAN_LOAD(n + 4); scan_step(fc, S0, S1, SL, VL, obase + (size_t)(n + 2) * 64 * D, w, et, jt, fr, fq);
        }
#undef SCAN_LOAD
        BAR_LDS();
    }
}

DI void p13_attn(const Ctx& X, const Args& a) {
    LAS bf16* KL = (LAS bf16*)X.lds;
    LAS bf16* VTL = (LAS bf16*)(X.lds + 256 * 72 * 2);
    const bf16* QN = (const bf16*)(X.ws + WS_QN); const bf16* KN = (const bf16*)(X.ws + WS_KN); const bf16* VT = (const bf16*)(X.ws + WS_VT);
    bf16* O = (bf16*)(X.ws + WS_O);
    const int fr = X.lane & 15, fq = X.lane >> 4;
    for (int unit = X.vcu; unit < NB * 2 * 16; unit += X.G) {
        const int b = unit >> 5, kvh = (unit >> 4) & 1, blk = unit & 15, s0 = blk * 128;
        BAR_LDS();
        for (int idx = X.tid; idx < 256 * 8; idx += NTHR) { const int key = idx >> 3, c8 = idx & 7; const int s = s0 - 128 + key;
            u32x4 val = (u32x4){0u, 0u, 0u, 0u};
            if (s >= 0) val = *(const u32x4*)(KN + ((size_t)(b * 2 + kvh) * SEQ + s) * 64 + c8 * 8);
            *(LAS u32x4*)(KL + key * 72 + c8 * 8) = val; }
        for (int idx = X.tid; idx < 64 * 32; idx += NTHR) { const int d = idx >> 5, c8 = idx & 31; const int s = s0 - 128 + c8 * 8;
            u32x4 val = (u32x4){0u, 0u, 0u, 0u};
            if (s >= 0) val = *(const u32x4*)(VT + ((size_t)(b * 2 + kvh) * 64 + d) * SEQ + s);
            *(LAS u32x4*)(VTL + d * 264 + c8 * 8) = val; }
        BAR_LDS();
        const int head = kvh * 8 + X.wave; const float sink = a.in[19][head];
        for (int qt = 0; qt < 8; ++qt) {
            const int tq = b * SEQ + s0 + 16 * qt + fr;
            bf16x8 qf[2];
#pragma unroll
            for (int kk = 0; kk < 2; ++kk) qf[kk] = *(const bf16x8*)(QN + (size_t)tq * D + head * 64 + kk * 32 + fq * 8);
            f32x4 st[10];
            float mx = sink;
            const int iq = 16 * qt + fr;
#pragma unroll
            for (int kt = 0; kt < 10; ++kt) { const int ktile = qt + kt, kc = ktile < 15 ? ktile : 15;
                f32x4 acc = (f32x4){0.f, 0.f, 0.f, 0.f};
#pragma unroll
                for (int kk = 0; kk < 2; ++kk) acc = MFMA16(*(const LAS bf16x8*)(KL + (16 * kc + fr) * 72 + kk * 32 + fq * 8), qf[kk], acc);
#pragma unroll
                for (int r = 0; r < 4; ++r) { const int jb = 16 * ktile + 4 * fq + r; const bool ok = (jb > iq) && (jb <= iq + 128) && (blk > 0 || jb >= 128);
                    acc[r] = ok ? acc[r] : -3.0e38f; mx = fmaxf(mx, acc[r]); }
                st[kt] = acc; }
            mx = fmaxf(mx, __shfl_xor(mx, 16)); mx = fmaxf(mx, __shfl_xor(mx, 32));
            float den = 0.f;
#pragma unroll
            for (int kt = 0; kt < 10; ++kt)
#pragma unroll
                for (int r = 0; r < 4; ++r) { const float p = st[kt][r] > -1.0e38f ? __expf(st[kt][r] - mx) : 0.f; st[kt][r] = p; den += p; }
            den += __shfl_xor(den, 16); den += __shfl_xor(den, 32);
            den += __expf(sink - mx);
            const float inv = 1.0f / den;
            f32x4 o[4];
#pragma unroll
            for (int dt = 0; dt < 4; ++dt) o[dt] = (f32x4){0.f, 0.f, 0.f, 0.f};
#pragma unroll
            for (int m = 0; m < 5; ++m) { const int kt0 = qt + 2 * m, kc0 = kt0 < 15 ? kt0 : 15, kc1 = (kt0 + 1) < 15 ? (kt0 + 1) : 15;
                u32x4 pw; pw.x = pk2(st[2 * m][0], st[2 * m][1]); pw.y = pk2(st[2 * m][2], st[2 * m][3]); pw.z = pk2(st[2 * m + 1][0], st[2 * m + 1][1]); pw.w = pk2(st[2 * m + 1][2], st[2 * m + 1][3]);
                const bf16x8 pf = __builtin_bit_cast(bf16x8, pw);
#pragma unroll
                for (int dt = 0; dt < 4; ++dt) { const u32x2 va = *(const LAS u32x2*)(VTL + (16 * dt + fr) * 264 + 16 * kc0 + 4 * fq), vb = *(const LAS u32x2*)(VTL + (16 * dt + fr) * 264 + 16 * kc1 + 4 * fq);
                    const u32x4 vw = (u32x4){va.x, va.y, vb.x, vb.y};
                    o[dt] = MFMA16(__builtin_bit_cast(bf16x8, vw), pf, o[dt]); } }
#pragma unroll
            for (int dt = 0; dt < 4; ++dt) { u32x2 p; p.x = pk2(o[dt][0] * inv, o[dt][1] * inv); p.y = pk2(o[dt][2] * inv, o[dt][3] * inv);
                *(u32x2*)(O + (size_t)tq * D + head * 64 + 16 * dt + 4 * fq) = p; }
        }
    }
}

constexpr int NPH = 19;
#ifndef N_LAUNCHES
#define N_LAUNCHES 1
#endif
__global__ void __launch_bounds__(NTHR, 2) fwd_kernel(Args args) {
    extern __shared__ __attribute__((aligned(16))) unsigned char lds_raw[];
    Ctx X;
    X.lds = (LAS unsigned char*)lds_raw;
    X.tid = threadIdx.x; X.lane = X.tid & 63; X.wave = __builtin_amdgcn_readfirstlane(X.tid >> 6);
    X.G = gridDim.x; { const int bx = blockIdx.x; X.vcu = (X.G % 8 == 0) ? (bx % 8) * (X.G / 8) + bx / 8 : bx; }
    X.gw = X.vcu * NWAVES + X.wave; X.NGW = X.G * NWAVES;
    X.ws = args.ws;
    volatile LAS unsigned* MISC = (volatile LAS unsigned*)(X.lds + MISC_OFF);
    if (X.tid < 64) MISC[X.tid] = 0u;
    __syncthreads();
    unsigned* ctl = (unsigned*)(X.ws + WS_CTL);
    XcdBarrier bar; bar.bar = ctl + CW_BAR; bar.x = 0; bar.st = nullptr;
    if (N_LAUNCHES == 1) bar = xcd_barrier_post(ctl + CW_BAR, MISC + 8);
    const int lo = args.ph_lo, hi = args.ph_hi;
#define IN(k) (lo <= (k) && (k) < hi)
#ifndef REPEAT_MASK
#define REPEAT_MASK 0u
#endif
#define PHASE(k, ...) if (IN(k)) { { __VA_ARGS__ } if ((REPEAT_MASK >> (k)) & 1u) { __VA_ARGS__ } }
#define SEAM(k) do { if (IN(k) && IN((k) + 1)) xcd_barrier(bar); } while (0)
    const Args& a = args;
    bf16* H = (bf16*)(X.ws + WS_H);
    const float* MOD = (const float*)(X.ws + WS_MOD);

    PHASE(0, p0_prologue(X, a);) SEAM(0);
    PHASE(1, p1_norm1(X, a);) SEAM(1);
    PHASE(2, pg8::PlainSched S{H, (const bf16*)(X.ws + WS_WIN_T), 64, 16, X.G, (int)blockIdx.x};
        pg8::EpiBf16 E{(bf16*)(X.ws + WS_PROJ), 4096};
        pg8::gemm_phase(X.lds, S, E);) SEAM(2);
    PHASE(3, p3_prep(X, a);) SEAM(3);
    PHASE(4, p4_scan(X, a);) SEAM(4);
    PHASE(5, p5_onorm(X, a);) SEAM(5);
    PHASE(6, pg8::PlainSched S{(const bf16*)(X.ws + WS_ON), (const bf16*)(X.ws + WS_WOUT_T), 64, 4, X.G, (int)blockIdx.x};
        pg8::EpiResid E{a.in[0], (float*)(X.ws + WS_X1), MOD + 2048};
        pg8::gemm_phase(X.lds, S, E);) SEAM(6);
    PHASE(7, p_norm_router(X, a, 0, (const float*)(X.ws + WS_X1));) SEAM(7);
    PHASE(8, moe_table(X, 0);
        pg8::MoeSched<8, true> S{H, (const bf16*)(X.ws + WS_UP_T), (const int*)(X.ws + WS_LIST), (const LAS int*)(X.lds + TAB_OFF), X.G, X.vcu, (size_t)2048 * 1024};
        pg8::EpiSwiglu E{(bf16*)(X.ws + WS_ACT), a.in[24]};
        pg8::gemm_phase(X.lds, S, E);) SEAM(8);
    PHASE(9, moe_table(X, 0);
        pg8::MoeSched<4, false> S{(const bf16*)(X.ws + WS_ACT), (const bf16*)(X.ws + WS_DOWN_T), (const int*)(X.ws + WS_LIST), (const LAS int*)(X.lds + TAB_OFF), X.G, X.vcu, (size_t)1024 * 1024};
        pg8::EpiDown E{(bf16*)(X.ws + WS_YS), a.in[26], (const int*)(X.ws + WS_LIST)};
        pg8::gemm_phase(X.lds, S, E);) SEAM(9);
    PHASE(10, p10_combine_norm(X, a);) SEAM(10);
    PHASE(11, pg8::KvqSched S{(const bf16*)(X.ws + WS_HKV), (const bf16*)(X.ws + WS_HQ), (const bf16*)(X.ws + WS_KV_T), (const bf16*)(X.ws + WS_WQ_T), X.G, X.vcu};
        pg8::EpiBf16 E{(bf16*)(X.ws + WS_QKV), 1280};
        pg8::gemm_phase(X.lds, S, E);) SEAM(11);
    PHASE(12, p12_qknorm(X, a);) SEAM(12);
    PHASE(13, p13_attn(X, a);) SEAM(13);
    PHASE(14, pg8::PlainSched S{(const bf16*)(X.ws + WS_O), (const bf16*)(X.ws + WS_BWOUT_T), 64, 4, X.G, (int)blockIdx.x};
        pg8::EpiResid E{(const float*)(X.ws + WS_X2), (float*)(X.ws + WS_X1), MOD + 6144 + 2048};
        pg8::gemm_phase(X.lds, S, E);) SEAM(14);
    PHASE(15, p_norm_router(X, a, 1, (const float*)(X.ws + WS_X1));) SEAM(15);
    PHASE(16, moe_table(X, 1);
        pg8::MoeSched<8, true> S{H, (const bf16*)(X.ws + WS_UP_T) + (size_t)32 * 2048 * 1024, (const int*)(X.ws + WS_LIST), (const LAS int*)(X.lds + TAB_OFF), X.G, X.vcu, (size_t)2048 * 1024};
        pg8::EpiSwiglu E{(bf16*)(X.ws + WS_ACT), a.in[24] + 32 * 2048};
        pg8::gemm_phase(X.lds, S, E);) SEAM(16);
    PHASE(17, moe_table(X, 1);
        pg8::MoeSched<4, false> S{(const bf16*)(X.ws + WS_ACT), (const bf16*)(X.ws + WS_DOWN_T) + (size_t)32 * 1024 * 1024, (const int*)(X.ws + WS_LIST), (const LAS int*)(X.lds + TAB_OFF), X.G, X.vcu, (size_t)1024 * 1024};
        pg8::EpiDown E{(bf16*)(X.ws + WS_YS), a.in[26] + 32 * 1024, (const int*)(X.ws + WS_LIST)};
        pg8::gemm_phase(X.lds, S, E);) SEAM(17);
    PHASE(18, p18_final(X, a);)
#undef IN
#undef SEAM
}

extern "C" void kernel_launch(void* const* d_in, const int* in_sizes, int n_in, void* d_out, int out_size, void* d_ws, size_t ws_size, hipStream_t stream) {
    static int grid = 0;
    if (grid == 0) {
        if (n_in != 27 || out_size != T * D || ws_size < WS_END) { fprintf(stderr, "kernel_launch: unexpected problem (n_in %d, out %d, ws %zu)\n", n_in, out_size, ws_size); grid = -1; return; }
        int dev = 0, cus = 0, per_cu = 0;
        if (hipGetDevice(&dev) != hipSuccess || hipDeviceGetAttribute(&cus, hipDeviceAttributeMultiprocessorCount, dev) != hipSuccess) { grid = -1; return; }
        if (hipFuncSetAttribute((const void*)fwd_kernel, hipFuncAttributeMaxDynamicSharedMemorySize, LDS_BYTES) != hipSuccess) { fprintf(stderr, "kernel_launch: hipFuncSetAttribute failed\n"); grid = -1; return; }
        if (hipOccupancyMaxActiveBlocksPerMultiprocessor(&per_cu, (const void*)fwd_kernel, NTHR, LDS_BYTES) != hipSuccess || per_cu < 1) { fprintf(stderr, "kernel_launch: occupancy query says %d\n", per_cu); (void)hipGetLastError(); }
        grid = cus;
    }
    if (grid < 0) return;
    (void)hipMemsetAsync((char*)d_ws + WS_CTL, 0, CTL_ZERO_BYTES, stream);
    Args a{};
    for (int i = 0; i < 27; ++i) a.in[i] = (const float*)d_in[i];
    a.pos = (const int*)d_in[2]; a.out = (float*)d_out; a.ws = (unsigned char*)d_ws;
    if (N_LAUNCHES == 1) { a.ph_lo = 0; a.ph_hi = NPH; hipLaunchKernelGGL(fwd_kernel, dim3(grid), dim3(NTHR), LDS_BYTES, stream, a); }
    else for (int p = 0; p < NPH; ++p) { a.ph_lo = p; a.ph_hi = p + 1; hipLaunchKernelGGL(fwd_kernel, dim3(grid), dim3(NTHR), LDS_BYTES, stream, a); }
}
```

```cpp
#include <hip/hip_runtime.h>
#include <cstdio>
#include <cstdint>

#define GAS __attribute__((address_space(1)))
#define LAS __attribute__((address_space(3)))
#define DI __device__ __forceinline__
typedef unsigned short bf16;
typedef short bf16x8 __attribute__((ext_vector_type(8)));
typedef short bf16x4 __attribute__((ext_vector_type(4)));
typedef float f32x4 __attribute__((ext_vector_type(4)));
typedef float f32x2 __attribute__((ext_vector_type(2)));
typedef unsigned u32x4 __attribute__((ext_vector_type(4)));
typedef unsigned u32x2 __attribute__((ext_vector_type(2)));

constexpr int NB = 8, SEQ = 2048, D = 1024, T = NB * SEQ;
constexpr int AH = 8, NCH = SEQ / 64;
constexpr int NE = 32, LISTCAP = 16384;
constexpr int MODW = 14336;
constexpr int NWAVES = 8, NTHR = 512;
constexpr float EPS = 1e-6f;

constexpr size_t MiB = 1u << 20;
constexpr size_t WS_CTL = 0, CTL_ZERO_BYTES = 1 * MiB;
constexpr size_t WS_MOD = 1 * MiB, WS_ROPE = 2 * MiB, WS_AB = 3 * MiB, WS_RGATE = 4 * MiB, WS_LIST = 5 * MiB, WS_GTOT = 7 * MiB;
constexpr size_t WS_WIN_T = 8 * MiB, WS_WOUT_T = 16 * MiB, WS_KV_T = 18 * MiB, WS_WQ_T = 19 * MiB, WS_BWOUT_T = 21 * MiB;
constexpr size_t WS_UP_T = 32 * MiB, WS_DOWN_T = 288 * MiB;
constexpr size_t WS_H = 416 * MiB, WS_HQ = 448 * MiB, WS_HKV = 480 * MiB, WS_PROJ = 512 * MiB;
constexpr size_t WS_UT = 640 * MiB, WS_WNEG = 704 * MiB, WS_QD = 736 * MiB, WS_KTT = 768 * MiB, WS_QK = 800 * MiB;
constexpr size_t WS_O = 816 * MiB, WS_ON = 848 * MiB, WS_X1 = 880 * MiB, WS_X2 = 944 * MiB;
constexpr size_t WS_ACT = 1008 * MiB, WS_YS = 1152 * MiB, WS_QKV = 1280 * MiB, WS_QN = 1320 * MiB, WS_KN = 1352 * MiB, WS_VT = 1356 * MiB;
constexpr size_t WS_END = 1360 * MiB;
constexpr int CW_CNT = 1024;
constexpr int CW_BAR = 4096;

constexpr int RING_BYTES = 131072;
constexpr int LDS_BYTES = 147456;
constexpr int MISC_OFF = LDS_BYTES - 2048;
constexpr int TAB_OFF = MISC_OFF + 256;

DI unsigned f2bf(float f) { unsigned u = __builtin_bit_cast(unsigned, f); return (u + 0x7fffu + ((u >> 16) & 1u)) >> 16; }
DI unsigned pk2(float lo, float hi) { return f2bf(lo) | (f2bf(hi) << 16); }
DI float bf2f(unsigned b) { return __builtin_bit_cast(float, b << 16); }
DI float bflo(unsigned w) { return __builtin_bit_cast(float, w << 16); }
DI float bfhi(unsigned w) { return __builtin_bit_cast(float, w & 0xffff0000u); }
DI float wave_sum(float v) {
#pragma unroll
    for (int o = 1; o < 64; o <<= 1) v += __shfl_xor(v, o);
    return v;
}
DI float sigmoidf_(float x) { return 1.f / (1.f + __expf(-x)); }
DI float siluf_(float x) { return x / (1.f + __expf(-x)); }
DI float silu_fast(float x) { return x * __builtin_amdgcn_rcpf(1.f + __expf(-x)); }
#define LDS_WAIT() asm volatile("s_waitcnt lgkmcnt(0)" ::: "memory")
#define VM_WAIT() asm volatile("s_waitcnt vmcnt(0)" ::: "memory")
#define BAR_LDS() do { asm volatile("s_waitcnt lgkmcnt(0)" ::: "memory"); __builtin_amdgcn_s_barrier(); asm volatile("" ::: "memory"); } while (0)
#define MFMA16(a, b, c) __builtin_amdgcn_mfma_f32_16x16x32_bf16((a), (b), (c), 0, 0, 0)

#define XB_TMO      128
#define XB_XCNT(j)  (256  + 64 * (j))
#define XB_XSUB(j)  (1280 + 64 * (j))
#define XB_XGEN(j)  (2304 + 64 * (j))
#define XB_TOP      3328
#define XB_TOPGEN   3392
#define XCD_BAR_WORDS 3456
#define XB_SPIN_CAP (1u << 18)
__device__ __forceinline__ unsigned xb_ld(unsigned* p)              { return __hip_atomic_load(p, __ATOMIC_RELAXED, __HIP_MEMORY_SCOPE_AGENT); }
__device__ __forceinline__ unsigned xb_add(unsigned* p, unsigned v) { return __hip_atomic_fetch_add(p, v, __ATOMIC_RELAXED, __HIP_MEMORY_SCOPE_AGENT); }
__device__ __forceinline__ unsigned xb_xcc_id() { return (unsigned)__builtin_amdgcn_s_getreg((3 << 11) | 20) & 0xFu; }
#define XB_SPIN(cond, bar) do { unsigned _sp = 0; while (cond) { __builtin_amdgcn_s_sleep(1); \
    if ((++_sp & 255u) == 0u) { if (xb_ld(&(bar)[XB_TMO])) break; if (_sp > XB_SPIN_CAP) { atomicAdd(&(bar)[XB_TMO], 1u); break; } } } } while (0)
struct XcdBarrier { unsigned* bar; unsigned x; volatile LAS unsigned* st; };
__device__ __forceinline__ XcdBarrier xcd_barrier_post(unsigned* bar, volatile LAS unsigned* st) {
    XcdBarrier b; b.bar = bar; b.x = xb_xcc_id(); b.st = st;
    if (threadIdx.x == 0) (void)xb_add(&bar[XB_XCNT(b.x)], 1u);
    return b;
}
__device__ __forceinline__ void xcd_barrier_complete(unsigned* bar, unsigned x, unsigned& nloc, unsigned& nx) {
    const unsigned G = gridDim.x * gridDim.y * gridDim.z;
    unsigned sum, cnt, mine, sp = 0u;
    for (;;) {
        sum = 0u; cnt = 0u; mine = 0u;
#pragma unroll
        for (unsigned j = 0; j < 16; ++j) { const unsigned c = xb_ld(&bar[XB_XCNT(j)]); sum += c; cnt += (c > 0u) ? 1u : 0u; mine = (j == x) ? c : mine; }
        if (sum == G) break;
        __builtin_amdgcn_s_sleep(1);
        if ((++sp & 255u) == 0u) { if (xb_ld(&bar[XB_TMO])) break; if (sp > XB_SPIN_CAP) { atomicAdd(&bar[XB_TMO], 1u); break; } }
    }
    nloc = mine > 0u ? mine : 1u; nx = cnt > 0u ? cnt : 1u;
}
__device__ __forceinline__ void xcd_barrier(const XcdBarrier& b) {
    asm volatile("s_waitcnt vmcnt(0)" ::: "memory");
    __syncthreads();
    if (threadIdx.x == 0) {
        unsigned* bar = b.bar;
        __builtin_amdgcn_s_waitcnt(0);
        unsigned nloc = b.st[0], nx = b.st[1];
        if (nloc == 0u) { xcd_barrier_complete(bar, b.x, nloc, nx); b.st[0] = nloc; b.st[1] = nx; }
        const unsigned old = xb_add(&bar[XB_XSUB(b.x)], 1u);
        const unsigned gen = old / nloc;
        if (old + 1u == (gen + 1u) * nloc) {
            __builtin_amdgcn_fence(__ATOMIC_RELEASE, "agent");
            asm volatile("s_waitcnt vmcnt(0)" ::: "memory");
            const unsigned og = xb_add(&bar[XB_TOP], 1u);
            const unsigned tg = og / nx;
            if (og + 1u == (tg + 1u) * nx) xb_add(&bar[XB_TOPGEN], 1u);
            else XB_SPIN(xb_ld(&bar[XB_TOPGEN]) == tg, bar);
            __builtin_amdgcn_fence(__ATOMIC_ACQUIRE, "agent");
            xb_add(&bar[XB_XGEN(b.x)], 1u);
            asm volatile("s_waitcnt vmcnt(0)" ::: "memory");
        } else {
            XB_SPIN(xb_ld(&bar[XB_XGEN(b.x)]) == gen, bar);
            __builtin_amdgcn_fence(__ATOMIC_ACQUIRE, "agent");
            asm volatile("s_waitcnt vmcnt(0)" ::: "memory");
        }
    }
    __syncthreads();
}

namespace pg8 {
constexpr int BM = 256, BK = 64, HALF = 128, HTB = HALF * BK * 2, KD = 1024;
__host__ __device__ __forceinline__ int lds_byte(int r, int c) { const int st = (r >> 4) * 2 + (c >> 5), rr = r & 15, cc = c & 31, ob = rr * 64 + cc * 2; return st * 1024 + (ob ^ (((ob >> 9) & 1) << 5)); }
__host__ __device__ __forceinline__ void stage_rc(int b, int& R, int& C) { const int st = b / 1024, sb = b % 1024, swz = sb ^ (((sb >> 9) & 1) << 5); R = (st >> 1) * 16 + swz / 64; C = (st & 1) * 32 + (swz % 64) / 2; }
__host__ __device__ __forceinline__ int perm32(int rho) { const int n = rho >> 4, i = rho & 15; return 8 * (i >> 2) + 4 * n + (i & 3); }
struct Unit { int pm, pn, e, rows, mt; };
__device__ __forceinline__ unsigned cvt_pk_bf16(float lo, float hi) { unsigned r; asm volatile("v_cvt_pk_bf16_f32 %0, %1, %2" : "=v"(r) : "v"(lo), "v"(hi)); return r; }

template <class Epi, class Sched>
__device__ __forceinline__ void gemm_phase(LAS unsigned char* lds, const Sched& S, const Epi& E) {
    const int tid = threadIdx.x, wid = __builtin_amdgcn_readfirstlane(tid >> 6), lane = tid & 63, wr = wid >> 2, wc = wid & 3, fr = lane & 15, fq = lane >> 4;
    constexpr int K = KD, nt = K / BK;
    int Rr[2], Cc[2]; unsigned voffB[2];
#pragma unroll
    for (int i = 0; i < 2; ++i) { stage_rc(tid * 16 + i * 8192, Rr[i], Cc[i]); const int Rb = Epi::PERM ? ((Rr[i] & ~31) + perm32(Rr[i] & 31)) : Rr[i]; voffB[i] = (unsigned)(Rb * K + Cc[i]) * 2u; }
    const size_t kstep = (size_t)(BK * 2);
    const size_t hstep = (size_t)HALF * K * 2;
    const unsigned ldsw = (unsigned)wid * 1024u;
    const int aoff = lds_byte(wr * 64 + fr, fq * 8), boff = lds_byte(wc * 32 + fr, fq * 8);
#define PG8_SA(b, h) (((b) * 2 + (h)) * HTB)
#define PG8_SB(b, h) ((4 + (b) * 2 + (h)) * HTB)
#define PG8_STAGE(bufoff, gbase, voff) do { _Pragma("unroll") for (int _i = 0; _i < 2; ++_i) \
        __builtin_amdgcn_global_load_lds((const unsigned*)((const char*)(gbase) + (voff)[_i]), (LAS unsigned*)(lds + (bufoff) + ldsw + _i * 8192), 16, 0, 0); } while (0)
#define PG8_LDA(dst, b, h) do { _Pragma("unroll") for (int m = 0; m < 4; ++m) _Pragma("unroll") for (int k = 0; k < 2; ++k) dst[m][k] = *(const LAS bf16x8*)(lds + PG8_SA(b, h) + aoff + m * 2048 + k * 1024); } while (0)
#define PG8_LDB(dst, b, h) do { _Pragma("unroll") for (int n = 0; n < 2; ++n) _Pragma("unroll") for (int k = 0; k < 2; ++k) dst[n][k] = *(const LAS bf16x8*)(lds + PG8_SB(b, h) + boff + n * 2048 + k * 1024); } while (0)
#define PG8_MMA(ai, bj, At, Bt) do { __builtin_amdgcn_s_setprio(1); _Pragma("unroll") for (int m = 0; m < 4; ++m) _Pragma("unroll") for (int n = 0; n < 2; ++n) _Pragma("unroll") for (int k = 0; k < 2; ++k) \
        acc[ai][bj][m][n] = __builtin_amdgcn_mfma_f32_16x16x32_bf16(Bt[n][k], At[m][k], acc[ai][bj][m][n], 0, 0, 0); __builtin_amdgcn_s_setprio(0); } while (0)
#define PG8_WAIT_V(n) asm volatile("s_waitcnt vmcnt(" #n ")" ::: "memory")
#define PG8_WAIT_L(n) asm volatile("s_waitcnt lgkmcnt(" #n ")" ::: "memory")
#define PG8_BAR __builtin_amdgcn_s_barrier()
#define PG8_SCHED __builtin_amdgcn_sched_barrier(0)
    Unit cur, nxt; int ui = 0;
    if (!S.next(0, cur)) return;
    f32x4 acc[2][2][4][2];
#pragma unroll
    for (int a = 0; a < 2; ++a)
#pragma unroll
        for (int b = 0; b < 2; ++b)
#pragma unroll
            for (int m = 0; m < 4; ++m)
#pragma unroll
                for (int n = 0; n < 2; ++n) acc[a][b][m][n] = (f32x4){0.f, 0.f, 0.f, 0.f};
    bf16x8 At[4][2], B0[2][2], B1[2][2];
    unsigned va[2][2], nva[2][2];
#pragma unroll
    for (int h = 0; h < 2; ++h)
#pragma unroll
        for (int i = 0; i < 2; ++i) va[h][i] = S.a_off(cur, h * HALF + Rr[i], Cc[i]);
    const char* cA = S.a_base(cur); const char* cB = S.b_base(cur);
    PG8_STAGE(PG8_SB(0, 0), cB, voffB); PG8_STAGE(PG8_SB(0, 1), cB + hstep, voffB); PG8_STAGE(PG8_SA(0, 0), cA, va[0]); PG8_STAGE(PG8_SA(0, 1), cA, va[1]);
    if (wr == 1) PG8_BAR;
    PG8_WAIT_V(2); PG8_BAR;
    PG8_STAGE(PG8_SB(1, 0), cB + kstep, voffB); PG8_STAGE(PG8_SA(1, 0), cA + kstep, va[0]); PG8_STAGE(PG8_SB(1, 1), cB + hstep + kstep, voffB);
    PG8_WAIT_V(6); PG8_BAR;
    for (;;) {
        const bool has_next = S.next(ui + 1, nxt);
        const char* nA = cA; const char* nB = cB;
#pragma unroll
        for (int h = 0; h < 2; ++h)
#pragma unroll
            for (int i = 0; i < 2; ++i) nva[h][i] = va[h][i];
        if (has_next) {
            nA = S.a_base(nxt); nB = S.b_base(nxt);
#pragma unroll
            for (int h = 0; h < 2; ++h)
#pragma unroll
                for (int i = 0; i < 2; ++i) nva[h][i] = S.a_off(nxt, h * HALF + Rr[i], Cc[i]);
        }
        asm volatile("" : "+v"(nva[0][0]), "+v"(nva[0][1]), "+v"(nva[1][0]), "+v"(nva[1][1]));
        for (int t = 0; t < nt; t += 2) {
            const bool last = (t == nt - 2);
            const char* a1 = cA + (size_t)(t + 1) * kstep;
            const char* a2 = last ? nA : cA + (size_t)(t + 2) * kstep; const char* b2 = last ? nB : cB + (size_t)(t + 2) * kstep;
            const char* a3 = a2 + kstep; const char* b3 = b2 + kstep;
            unsigned v2[2][2];
#pragma unroll
            for (int h = 0; h < 2; ++h)
#pragma unroll
                for (int i = 0; i < 2; ++i) v2[h][i] = last ? nva[h][i] : va[h][i];
            PG8_LDB(B0, 0, 0); PG8_LDB(B1, 0, 1); PG8_SCHED; PG8_LDA(At, 0, 0); PG8_STAGE(PG8_SA(1, 1), a1, va[1]);
            PG8_WAIT_V(8); PG8_WAIT_L(0); PG8_BAR; PG8_MMA(0, 0, At, B0); PG8_MMA(0, 1, At, B1); PG8_BAR; PG8_SCHED;
            PG8_LDA(At, 0, 1); PG8_STAGE(PG8_SB(0, 0), b2, voffB); PG8_STAGE(PG8_SB(0, 1), b2 + hstep, voffB); PG8_STAGE(PG8_SA(0, 0), a2, v2[0]);
            PG8_WAIT_V(8); PG8_WAIT_L(0); PG8_BAR; PG8_MMA(1, 0, At, B0); PG8_MMA(1, 1, At, B1); PG8_BAR; PG8_SCHED;
            PG8_LDB(B0, 1, 0); PG8_LDB(B1, 1, 1); PG8_SCHED; PG8_LDA(At, 1, 0); PG8_STAGE(PG8_SA(0, 1), a2, v2[1]);
            PG8_WAIT_V(8); PG8_WAIT_L(0); PG8_BAR; PG8_MMA(0, 0, At, B0); PG8_MMA(0, 1, At, B1); PG8_BAR; PG8_SCHED;
            PG8_LDA(At, 1, 1); PG8_STAGE(PG8_SB(1, 0), b3, voffB); PG8_STAGE(PG8_SB(1, 1), b3 + hstep, voffB); PG8_STAGE(PG8_SA(1, 0), a3, v2[0]);
            PG8_WAIT_V(8); PG8_WAIT_L(0); PG8_BAR; PG8_MMA(1, 0, At, B0); PG8_MMA(1, 1, At, B1); PG8_BAR; PG8_SCHED;
        }
        E(acc, cur, wr, wc, fr, fq);
        if (!has_next) break;
#pragma unroll
        for (int a = 0; a < 2; ++a)
#pragma unroll
            for (int b = 0; b < 2; ++b)
#pragma unroll
                for (int m = 0; m < 4; ++m)
#pragma unroll
                    for (int n = 0; n < 2; ++n) acc[a][b][m][n] = (f32x4){0.f, 0.f, 0.f, 0.f};
        cur = nxt; cA = nA; cB = nB; ++ui;
#pragma unroll
        for (int h = 0; h < 2; ++h)
#pragma unroll
            for (int i = 0; i < 2; ++i) va[h][i] = nva[h][i];
    }
    PG8_WAIT_V(0);
    if (wr == 0) PG8_BAR;
    PG8_BAR;
#undef PG8_SA
#undef PG8_SB
#undef PG8_STAGE
#undef PG8_LDA
#undef PG8_LDB
#undef PG8_MMA
#undef PG8_WAIT_V
#undef PG8_WAIT_L
#undef PG8_BAR
#undef PG8_SCHED
}

struct PlainSched {
    const bf16* A; const bf16* Bt; int nM, nN, G, c;
    __device__ __forceinline__ bool next(int i, Unit& u) const {
        const int nwg = nM * nN; const long L = (long)i * G + c; if (L >= nwg) return false;
        int wgid = (int)L; { const int q = nwg / 8, r = nwg % 8, xcd = wgid % 8, off = wgid / 8; wgid = (xcd < r ? xcd * (q + 1) : r * (q + 1) + (xcd - r) * q) + off; }
        const int nig = 8 * nN, gid = wgid / nig, fm = gid * 8, gsz = (nM - fm) < 8 ? (nM - fm) : 8;
        u.pm = fm + ((wgid % nig) % gsz); u.pn = (wgid % nig) / gsz; u.e = 0; u.rows = 256; u.mt = 0; return true;
    }
    __device__ __forceinline__ const char* a_base(const Unit& u) const { return (const char*)A + (size_t)u.pm * (256 * KD * 2); }
    __device__ __forceinline__ const char* b_base(const Unit& u) const { return (const char*)Bt + (size_t)u.pn * (256 * KD * 2); }
    __device__ __forceinline__ unsigned a_off(const Unit&, int row, int col) const { return (unsigned)(row * KD + col) * 2u; }
};
struct KvqSched {
    const bf16* Akv; const bf16* Aq; const bf16* Bkv; const bf16* Bq; int G, c;
    __device__ __forceinline__ bool next(int i, Unit& u) const {
        const int L = i * G + c; if (L >= 64 * 5) return false;
        u.pm = L / 5; u.pn = L % 5; u.e = 0; u.rows = 256; u.mt = 0; return true;
    }
    __device__ __forceinline__ const char* a_base(const Unit& u) const { return (const char*)(u.pn == 0 ? Akv : Aq) + (size_t)u.pm * (256 * KD * 2); }
    __device__ __forceinline__ const char* b_base(const Unit& u) const { return u.pn == 0 ? (const char*)Bkv : (const char*)Bq + (size_t)(u.pn - 1) * (256 * KD * 2); }
    __device__ __forceinline__ unsigned a_off(const Unit&, int row, int col) const { return (unsigned)(row * KD + col) * 2u; }
};
template <int NPN, bool GATHER>
struct MoeSched {
    const bf16* A; const bf16* Bt; const int* list; const LAS int* tab; int G, c; size_t bstride;
    __device__ __forceinline__ bool next(int i, Unit& u) const {
        const int ntiles = tab[32 + 32]; const int L = i * G + c; const int tile = L / NPN;
        if (tile >= ntiles) return false;
        const int e = tab[80 + tile]; u.pm = tile; u.pn = L % NPN; u.e = e; u.mt = tile - tab[32 + e];
        const int rem = tab[e] - u.mt * 256; u.rows = rem < 256 ? rem : 256; return true;
    }
    __device__ __forceinline__ const char* a_base(const Unit& u) const { return GATHER ? (const char*)A : (const char*)A + (size_t)u.pm * (256 * KD * 2); }
    __device__ __forceinline__ const char* b_base(const Unit& u) const { return (const char*)(Bt + (size_t)u.e * bstride) + (size_t)u.pn * (256 * KD * 2); }
    __device__ __forceinline__ unsigned a_off(const Unit& u, int row, int col) const {
        if (!GATHER) return (unsigned)(row * KD + col) * 2u;
        const int tok = row < u.rows ? (list[u.e * LISTCAP + u.mt * 256 + row] >> 2) : 0;
        return (unsigned)(tok * KD + col) * 2u;
    }
};

struct EpiBf16 {
    static constexpr bool PERM = true;
    bf16* O; int ldc;
    __device__ __forceinline__ void operator()(const f32x4 (&acc)[2][2][4][2], const Unit& u, int wr, int wc, int fr, int fq) const {
        const int row0 = u.pm * BM + wr * 64 + fr, col0 = u.pn * BM + wc * 32 + 8 * fq;
#pragma unroll
        for (int ai = 0; ai < 2; ++ai)
#pragma unroll
            for (int m = 0; m < 4; ++m) { bf16* rowp = O + (size_t)(row0 + ai * HALF + m * 16) * ldc + col0;
#pragma unroll
                for (int bj = 0; bj < 2; ++bj) { const f32x4 v0 = acc[ai][bj][m][0], v1 = acc[ai][bj][m][1];
                    u32x4 w; w.x = cvt_pk_bf16(v0[0], v0[1]); w.y = cvt_pk_bf16(v0[2], v0[3]); w.z = cvt_pk_bf16(v1[0], v1[1]); w.w = cvt_pk_bf16(v1[2], v1[3]);
                    *(u32x4*)(rowp + bj * HALF) = w; } }
    }
};
struct EpiResid {
    static constexpr bool PERM = false;
    const float* base; float* out; const float* gate;
    __device__ __forceinline__ void operator()(const f32x4 (&acc)[2][2][4][2], const Unit& u, int wr, int wc, int fr, int fq) const {
        const int row0 = u.pm * BM + wr * 64 + fr, col0 = u.pn * BM + wc * 32 + 4 * fq;
        const float* gp = gate + (size_t)(u.pm / 8) * MODW + col0;
        f32x4 gv[2][2];
#pragma unroll
        for (int bj = 0; bj < 2; ++bj)
#pragma unroll
            for (int n = 0; n < 2; ++n) gv[bj][n] = *(const f32x4*)(gp + bj * HALF + n * 16);
#pragma unroll
        for (int ai = 0; ai < 2; ++ai)
#pragma unroll
            for (int m = 0; m < 4; ++m) { const size_t off = (size_t)(row0 + ai * HALF + m * 16) * D + col0;
#pragma unroll
                for (int bj = 0; bj < 2; ++bj)
#pragma unroll
                    for (int n = 0; n < 2; ++n) { const f32x4 bs = *(const f32x4*)(base + off + bj * HALF + n * 16);
                        *(f32x4*)(out + off + bj * HALF + n * 16) = bs + gv[bj][n] * acc[ai][bj][m][n]; }
                asm volatile("" ::: "memory"); }
    }
};
struct EpiSwiglu {
    static constexpr bool PERM = true;
    bf16* act; const float* upb;
    __device__ __forceinline__ void operator()(const f32x4 (&acc)[2][2][4][2], const Unit& u, int wr, int wc, int fr, int fq) const {
        const int row0 = u.pm * BM + wr * 64 + fr, j0 = u.pn * HALF + wc * 32 + 8 * fq;
        const float* bp = upb + (size_t)u.e * 2048 + j0;
        f32x4 bg[2], bl[2];
#pragma unroll
        for (int n = 0; n < 2; ++n) { bg[n] = *(const f32x4*)(bp + 4 * n); bl[n] = *(const f32x4*)(bp + 1024 + 4 * n); }
#pragma unroll
        for (int ai = 0; ai < 2; ++ai)
#pragma unroll
            for (int m = 0; m < 4; ++m) { float o[8];
#pragma unroll
                for (int n = 0; n < 2; ++n) { const f32x4 g = acc[ai][0][m][n] + bg[n], l = acc[ai][1][m][n] + bl[n];
#pragma unroll
                    for (int j = 0; j < 4; ++j) { const float gg = fminf(g[j], 7.0f), ll = fminf(fmaxf(l[j], -7.0f), 7.0f);
                        o[4 * n + j] = gg * __builtin_amdgcn_rcpf(1.f + __expf(-1.702f * gg)) * (ll + 1.0f); } }
                u32x4 w; w.x = cvt_pk_bf16(o[0], o[1]); w.y = cvt_pk_bf16(o[2], o[3]); w.z = cvt_pk_bf16(o[4], o[5]); w.w = cvt_pk_bf16(o[6], o[7]);
                *(u32x4*)(act + (size_t)(row0 + ai * HALF + m * 16) * 1024 + j0) = w; }
    }
};
struct EpiDown {
    static constexpr bool PERM = true;
    bf16* ys; const float* dnb; const int* list;
    __device__ __forceinline__ void operator()(const f32x4 (&acc)[2][2][4][2], const Unit& u, int wr, int wc, int fr, int fq) const {
        const int r0 = wr * 64 + fr, col0 = u.pn * BM + wc * 32 + 8 * fq;
        const float* bp = dnb + (size_t)u.e * 1024 + col0;
        f32x4 bv[2][2];
#pragma unroll
        for (int bj = 0; bj < 2; ++bj)
#pragma unroll
            for (int n = 0; n < 2; ++n) bv[bj][n] = *(const f32x4*)(bp + bj * HALF + 4 * n);
        const int* lp = list + u.e * LISTCAP + u.mt * 256;
#pragma unroll
        for (int ai = 0; ai < 2; ++ai)
#pragma unroll
            for (int m = 0; m < 4; ++m) { const int r = r0 + ai * HALF + m * 16;
                if (r < u.rows) { const int slot = lp[r]; bf16* rowp = ys + (size_t)slot * 1024 + col0;
#pragma unroll
                    for (int bj = 0; bj < 2; ++bj) { const f32x4 v0 = acc[ai][bj][m][0] + bv[bj][0], v1 = acc[ai][bj][m][1] + bv[bj][1];
                        u32x4 w; w.x = cvt_pk_bf16(v0[0], v0[1]); w.y = cvt_pk_bf16(v0[2], v0[3]); w.z = cvt_pk_bf16(v1[0], v1[1]); w.w = cvt_pk_bf16(v1[2], v1[3]);
                        *(u32x4*)(rowp + bj * HALF) = w; } } }
    }
};
}

struct Args { const float* in[27]; const int* pos; float* out; unsigned char* ws; int ph_lo, ph_hi; };

struct Ctx {
    LAS unsigned char* lds; int tid, lane, wave, vcu, G, gw, NGW;
    unsigned char* ws;
};

DI void tr_item(const float* W, int ldw, int k0, int n0, bf16* WT, int dst_row0, LAS float* scr, int lane) {
    float ld[64];
#pragma unroll
    for (int i = 0; i < 64; ++i) ld[i] = __builtin_nontemporal_load(W + (size_t)(k0 + i) * ldw + n0 + lane);
#pragma unroll
    for (int i = 0; i < 64; ++i) scr[i * 65 + lane] = ld[i];
    LDS_WAIT(); asm volatile("" ::: "memory");
    const int c = lane & 7;
#pragma unroll
    for (int j = 0; j < 8; ++j) { const int n = (lane >> 3) + 8 * j; const LAS float* s = scr + (8 * c) * 65 + n;
        u32x4 o; o.x = pk2(s[0 * 65], s[1 * 65]); o.y = pk2(s[2 * 65], s[3 * 65]); o.z = pk2(s[4 * 65], s[5 * 65]); o.w = pk2(s[6 * 65], s[7 * 65]);
        *(GAS u32x4*)(WT + (size_t)(dst_row0 + n) * 1024 + k0 + 8 * c) = o; }
    LDS_WAIT(); asm volatile("" ::: "memory");
}

DI void p0_prologue(const Ctx& X, const Args& a) {
    {
        LAS float* CA = (LAS float*)X.lds;
        LAS float* RED = (LAS float*)(X.lds + 32768);
        const float* c = a.in[1];
        for (int idx = X.tid; idx < 8192; idx += NTHR) { const int b = idx >> 10, d = idx & 1023; CA[d * 8 + b] = siluf_(c[idx]); }
        __syncthreads();
        float* MOD = (float*)(X.ws + WS_MOD);
        for (int g = X.vcu; g < 224; g += X.G) {
            const float* W; const float* bias; int ld, outcol;
            if (g < 96) { W = a.in[3] + 64 * g; ld = 6144; bias = a.in[4] + 64 * g; outcol = 64 * g; }
            else if (g < 192) { W = a.in[3] + (size_t)1024 * 6144 + 64 * (g - 96); ld = 6144; bias = a.in[4] + 6144 + 64 * (g - 96); outcol = 6144 + 64 * (g - 96); }
            else { W = a.in[12] + 64 * (g - 192); ld = 2048; bias = a.in[13] + 64 * (g - 192); outcol = 12288 + 64 * (g - 192); }
            float acc[8];
#pragma unroll
            for (int b = 0; b < 8; ++b) acc[b] = 0.f;
            const int d0 = X.wave * 128;
#pragma unroll 8
            for (int dd = 0; dd < 128; ++dd) { const int d = d0 + dd; const float wv = W[(size_t)d * ld + X.lane];
                const f32x4 c0 = *(const LAS f32x4*)(CA + d * 8), c1 = *(const LAS f32x4*)(CA + d * 8 + 4);
                acc[0] += c0[0] * wv; acc[1] += c0[1] * wv; acc[2] += c0[2] * wv; acc[3] += c0[3] * wv;
                acc[4] += c1[0] * wv; acc[5] += c1[1] * wv; acc[6] += c1[2] * wv; acc[7] += c1[3] * wv; }
#pragma unroll
            for (int b = 0; b < 8; ++b) RED[(X.wave * 8 + b) * 64 + X.lane] = acc[b];
            __syncthreads();
            { const int b = X.tid >> 6, col = X.tid & 63; float s = bias[col];
#pragma unroll
              for (int w = 0; w < 8; ++w) s += RED[(w * 8 + b) * 64 + col];
              MOD[(size_t)b * MODW + outcol + col] = s; }
            __syncthreads();
        }
    }
    {
        float* ROPE = (float*)(X.ws + WS_ROPE);
        for (int idx = X.gw * 64 + X.lane; idx < T * 8; idx += X.NGW * 64) {
            const int t = idx >> 3, i = idx & 7;
            const float invf = i == 0 ? 1.0f : i == 1 ? 0.19392274f : i == 2 ? 0.03760603f : i == 3 ? 0.0072926646f : i == 4 ? 0.0014142136f : i == 5 ? 0.0002742482f : i == 6 ? 5.3182957e-05f : 1.0313385e-05f;
            const float ang = (float)a.pos[t] * invf;
            double rev = (double)ang * 0.15915494309189533577; rev -= __builtin_rint(rev);
            const float fr = (float)rev;
            ROPE[t * 16 + i] = __builtin_amdgcn_cosf(fr); ROPE[t * 16 + 8 + i] = __builtin_amdgcn_sinf(fr);
        }
    }
    {
        LAS float* scr = (LAS float*)(X.lds + X.wave * 16640);
        bf16* WIN_T = (bf16*)(X.ws + WS_WIN_T); bf16* WOUT_T = (bf16*)(X.ws + WS_WOUT_T); bf16* KV_T = (bf16*)(X.ws + WS_KV_T);
        bf16* WQ_T = (bf16*)(X.ws + WS_WQ_T); bf16* BWOUT_T = (bf16*)(X.ws + WS_BWOUT_T); bf16* UP_T = (bf16*)(X.ws + WS_UP_T); bf16* DOWN_T = (bf16*)(X.ws + WS_DOWN_T);
        constexpr int I0 = 16 * 64, I1 = 256, I2 = 16 * 4, I3 = 256, I4 = 256, I5 = 64 * 512, I6 = 64 * 256;
        constexpr int NITEMS = I0 + I1 + I2 + I3 + I4 + I5 + I6;
        __syncthreads();
        for (int it = X.gw; it < NITEMS; it += X.NGW) {
            int r = it;
            if (r < I0) { tr_item(a.in[6], 4112, 64 * (r / 64), 64 * (r % 64), WIN_T, 64 * (r % 64), scr, X.lane); continue; } r -= I0;
            if (r < I1) { tr_item(a.in[11], 1024, 64 * (r / 16), 64 * (r % 16), WOUT_T, 64 * (r % 16), scr, X.lane); continue; } r -= I1;
            if (r < I2) { tr_item(a.in[15], 256, 64 * (r / 4), 64 * (r % 4), KV_T, 64 * (r % 4), scr, X.lane); continue; } r -= I2;
            if (r < I3) { tr_item(a.in[17], 1024, 64 * (r / 16), 64 * (r % 16), WQ_T, 64 * (r % 16), scr, X.lane); continue; } r -= I3;
            if (r < I4) { tr_item(a.in[20], 1024, 64 * (r / 16), 64 * (r % 16), BWOUT_T, 64 * (r % 16), scr, X.lane); continue; } r -= I4;
            if (r < I5) { const int mi = r >> 9, rr = r & 511, kb = rr >> 5, nb = rr & 31, n0 = 64 * nb, half = n0 >> 10, j0 = n0 & 1023;
                tr_item(a.in[23] + (size_t)mi * 1024 * 2048, 2048, 64 * kb, n0, UP_T + (size_t)mi * 2048 * 1024, (j0 >> 7) * 256 + half * 128 + (j0 & 127), scr, X.lane); continue; } r -= I5;
            { const int mi = r >> 8, rr = r & 255, kb = rr >> 4, nb = rr & 15;
                tr_item(a.in[25] + (size_t)mi * 1024 * 1024, 1024, 64 * kb, 64 * nb, DOWN_T + (size_t)mi * 1024 * 1024, 64 * nb, scr, X.lane); }
        }
    }
}

DI void load_affine(const float* gain, const float* scale, const float* shift, int lane, f32x4 (&A)[4], f32x4 (&Bv)[4]) {
#pragma unroll
    for (int j = 0; j < 4; ++j) { const int d = 4 * lane + 256 * j; const f32x4 g = *(const f32x4*)(gain + d), sc = *(const f32x4*)(scale + d); A[j] = g * (sc + 1.0f); Bv[j] = *(const f32x4*)(shift + d); }
}
DI void store_bf16_row(bf16* row, int lane, const f32x4 (&h)[4]) {
#pragma unroll
    for (int j = 0; j < 4; ++j) { u32x2 w; w.x = pk2(h[j][0], h[j][1]); w.y = pk2(h[j][2], h[j][3]); *(u32x2*)(row + 4 * lane + 256 * j) = w; }
}
DI float row_rs(const f32x4 (&v)[4]) {
    float ss = 0.f;
#pragma unroll
    for (int j = 0; j < 4; ++j) ss += (v[j][0] * v[j][0] + v[j][1] * v[j][1]) + (v[j][2] * v[j][2] + v[j][3] * v[j][3]);
    return rsqrtf(wave_sum(ss) * (1.0f / 1024.0f) + EPS);
}

template <int NCH8>
DI void skinny4(const f32x4 (&hv)[4][4], const LAS float* WTL, int lane, float (&res)[NCH8]) {
#pragma unroll
    for (int q = 0; q < NCH8; ++q) res[q] = 0.f;
#pragma unroll 1
    for (int oc = 0; oc < NCH8; ++oc) {
        float p[32];
#pragma unroll
        for (int o = 0; o < 8; ++o) { f32x4 w[4];
#pragma unroll
            for (int j = 0; j < 4; ++j) w[j] = *(const LAS f32x4*)(WTL + (oc * 8 + o) * 1024 + 4 * lane + 256 * j);
#pragma unroll
            for (int tt = 0; tt < 4; ++tt) { float s = 0.f;
#pragma unroll
                for (int j = 0; j < 4; ++j) s += (hv[tt][j][0] * w[j][0] + hv[tt][j][1] * w[j][1]) + (hv[tt][j][2] * w[j][2] + hv[tt][j][3] * w[j][3]);
                p[tt * 8 + o] = s; }
            }
        { const bool hi = (lane & 32) != 0;
#pragma unroll
          for (int i = 0; i < 16; ++i) { const float keep = hi ? p[16 + i] : p[i], send = hi ? p[i] : p[16 + i]; p[i] = keep + __shfl_xor(send, 32); } }
        { const bool hi = (lane & 16) != 0;
#pragma unroll
          for (int i = 0; i < 8; ++i) { const float keep = hi ? p[8 + i] : p[i], send = hi ? p[i] : p[8 + i]; p[i] = keep + __shfl_xor(send, 16); } }
        { const bool hi = (lane & 8) != 0;
#pragma unroll
          for (int i = 0; i < 4; ++i) { const float keep = hi ? p[4 + i] : p[i], send = hi ? p[i] : p[4 + i]; p[i] = keep + __shfl_xor(send, 8); } }
        { const bool hi = (lane & 4) != 0;
#pragma unroll
          for (int i = 0; i < 2; ++i) { const float keep = hi ? p[2 + i] : p[i], send = hi ? p[i] : p[2 + i]; p[i] = keep + __shfl_xor(send, 4); } }
        { const bool hi = (lane & 2) != 0; const float keep = hi ? p[1] : p[0], send = hi ? p[0] : p[1]; p[0] = keep + __shfl_xor(send, 2); }
        const float rsum = p[0] + __shfl_xor(p[0], 1);
#pragma unroll
        for (int q = 0; q < NCH8; ++q) res[q] = (q == oc) ? rsum : res[q];
    }
}

DI void p1_norm1(const Ctx& X, const Args& a) {
    LAS float* WTL = (LAS float*)X.lds;
    const float* w_in = a.in[6];
    for (int idx = X.tid; idx < 16384; idx += NTHR) { const int d = idx >> 4, o = idx & 15; WTL[o * 1024 + d] = w_in[(size_t)d * 4112 + 4096 + o]; }
    __syncthreads();
    const float* MOD = (const float*)(X.ws + WS_MOD); bf16* H = (bf16*)(X.ws + WS_H); float* AB = (float*)(X.ws + WS_AB);
    for (int tb = X.gw; tb < T / 4; tb += X.NGW) {
        const int t0 = tb * 4, b = t0 / SEQ;
        f32x4 A[4], Bv[4]; load_affine(a.in[5], MOD + (size_t)b * MODW + 1024, MOD + (size_t)b * MODW, X.lane, A, Bv);
        f32x4 hv[4][4];
#pragma unroll
        for (int tt = 0; tt < 4; ++tt) { const float* xr = a.in[0] + (size_t)(t0 + tt) * D;
#pragma unroll
            for (int j = 0; j < 4; ++j) hv[tt][j] = *(const f32x4*)(xr + 4 * X.lane + 256 * j); }
#pragma unroll
        for (int tt = 0; tt < 4; ++tt) { const float r = row_rs(hv[tt]);
#pragma unroll
            for (int j = 0; j < 4; ++j) hv[tt][j] = hv[tt][j] * r * A[j] + Bv[j];
            store_bf16_row(H + (size_t)(t0 + tt) * D, X.lane, hv[tt]); }
        float res[2]; skinny4<2>(hv, WTL, X.lane, res);
        if ((X.lane & 1) == 0) { float* ab = AB + (size_t)(t0 + (X.lane >> 4)) * 16 + ((X.lane >> 1) & 7); ab[0] = res[0]; ab[8] = res[1]; }
    }
}

DI void p_norm_router(const Ctx& X, const Args& a, int layer, const float* xin) {
    LAS float* WTL = (LAS float*)X.lds;
    LAS int* HIST = (LAS int*)(X.lds + TAB_OFF); LAS int* BASE = HIST + 32; LAS int* ASG = HIST + 64;
    const float* rw = a.in[21] + (size_t)layer * 1024 * 32; const float* rb = a.in[22] + layer * 32;
    for (int idx = X.tid; idx < 32768; idx += NTHR) { const int d = idx >> 5, o = idx & 31; WTL[o * 1024 + d] = rw[idx]; }
    const float* MOD = (const float*)(X.ws + WS_MOD) + layer * 6144; bf16* H = (bf16*)(X.ws + WS_H);
    float* RGATE = (float*)(X.ws + WS_RGATE); int* LIST = (int*)(X.ws + WS_LIST);
    unsigned* gcnt = (unsigned*)(X.ws + WS_CTL) + CW_CNT + 64 * layer;
    const float* gain = a.in[5] + (size_t)(layer * 2 + 1) * D;
    for (int tb = X.vcu; tb < T / 64; tb += X.G) {
        if (X.tid < 32) HIST[X.tid] = 0;
        __syncthreads();
        const int tw0 = tb * 64 + X.wave * 8, b = tw0 / SEQ;
        int ln0 = X.lane; asm volatile("" : "+v"(ln0));
#pragma unroll 1
        for (int grp = 0; grp < 2; ++grp) {
            int ln = ln0; asm volatile("" : "+v"(ln));
            const int myo = (ln >> 1) & 7;
            const int t0 = tw0 + grp * 4;
            f32x4 A[4], Bv[4]; load_affine(gain, MOD + (size_t)b * MODW + 4096, MOD + (size_t)b * MODW + 3072, ln, A, Bv);
            f32x4 hv[4][4];
#pragma unroll
            for (int tt = 0; tt < 4; ++tt) { const float* xr = xin + (size_t)(t0 + tt) * D;
#pragma unroll
                for (int j = 0; j < 4; ++j) hv[tt][j] = *(const f32x4*)(xr + 4 * ln + 256 * j); }
#pragma unroll
            for (int tt = 0; tt < 4; ++tt) { const float r = row_rs(hv[tt]);
#pragma unroll
                for (int j = 0; j < 4; ++j) hv[tt][j] = hv[tt][j] * r * A[j] + Bv[j];
                store_bf16_row(H + (size_t)(t0 + tt) * D, ln, hv[tt]); }
            float lgv[4]; skinny4<4>(hv, WTL, ln, lgv);
#pragma unroll
            for (int oc = 0; oc < 4; ++oc) lgv[oc] += rb[oc * 8 + myo];
            float tv[4]; int ti[4];
#pragma unroll
            for (int k = 0; k < 4; ++k) { float best = lgv[0]; int bi = myo;
#pragma unroll
                for (int oc = 1; oc < 4; ++oc) if (lgv[oc] > best) { best = lgv[oc]; bi = oc * 8 + myo; }
#pragma unroll
                for (int o = 1; o < 16; o <<= 1) { const float ov = __shfl_xor(best, o); const int oi = __shfl_xor(bi, o); if (ov > best || (ov == best && oi < bi)) { best = ov; bi = oi; } }
                tv[k] = best; ti[k] = bi;
#pragma unroll
                for (int oc = 0; oc < 4; ++oc) if (oc * 8 + myo == bi) lgv[oc] = -3.0e38f; }
            const float e1 = __expf(tv[1] - tv[0]), e2 = __expf(tv[2] - tv[0]), e3 = __expf(tv[3] - tv[0]); const float inv = 1.0f / (1.0f + e1 + e2 + e3);
            const int k = ln & 15, tl = grp * 4 + (ln >> 4);
            if (k < 4) { const int e = k == 0 ? ti[0] : k == 1 ? ti[1] : k == 2 ? ti[2] : ti[3];
                const float gt = (k == 0 ? 1.0f : k == 1 ? e1 : k == 2 ? e2 : e3) * inv;
                const int lr = atomicAdd((int*)&HIST[e], 1);
                ASG[(X.wave * 8 + tl) * 4 + k] = (e << 16) | lr; RGATE[(size_t)(tw0 + tl) * 4 + k] = gt; }
        }
        __syncthreads();
        if (X.tid < 32) BASE[X.tid] = (int)__hip_atomic_fetch_add(gcnt + X.tid, (unsigned)HIST[X.tid], __ATOMIC_RELAXED, __HIP_MEMORY_SCOPE_AGENT);
        __syncthreads();
        if (X.tid < 256) { const int av = ASG[X.tid], e = av >> 16, lr = av & 0xffff; LIST[e * LISTCAP + BASE[e] + lr] = tb * 256 + X.tid; }
        __syncthreads();
    }
}

DI void moe_table(const Ctx& X, int layer) {
    LAS int* tab = (LAS int*)(X.lds + TAB_OFF);
    const unsigned* gcnt = (const unsigned*)(X.ws + WS_CTL) + CW_CNT + 64 * layer;
    if (X.tid < 32) tab[X.tid] = (int)__hip_atomic_load(gcnt + X.tid, __ATOMIC_RELAXED, __HIP_MEMORY_SCOPE_AGENT);
    __syncthreads();
    if (X.tid == 0) { int s = 0; for (int e = 0; e < 32; ++e) { tab[32 + e] = s; s += (tab[e] + 255) >> 8; } tab[64] = s; }
    __syncthreads();
    if (X.tid < 32) { const int s0 = tab[32 + X.tid], s1 = tab[33 + X.tid]; for (int q = s0; q < s1; ++q) tab[80 + q] = X.tid; }
    __syncthreads();
}

DI void p10_combine_norm(const Ctx& X, const Args& a) {
    const float* MOD = (const float*)(X.ws + WS_MOD); const float* X1 = (const float*)(X.ws + WS_X1); float* X2 = (float*)(X.ws + WS_X2);
    const bf16* YS = (const bf16*)(X.ws + WS_YS); const float* RGATE = (const float*)(X.ws + WS_RGATE);
    bf16* HKV = (bf16*)(X.ws + WS_HKV); bf16* HQ = (bf16*)(X.ws + WS_HQ);
    for (int tb = X.gw; tb < T / 8; tb += X.NGW) {
        const int t0 = tb * 8, b = t0 / SEQ; const float* mb = MOD + (size_t)b * MODW;
        f32x4 G2[4], Ak[4], Bk[4], Aq[4], Bq[4];
#pragma unroll
        for (int j = 0; j < 4; ++j) G2[j] = *(const f32x4*)(mb + 5120 + 4 * X.lane + 256 * j);
        load_affine(a.in[14], mb + 12288 + 1024, mb + 12288, X.lane, Ak, Bk);
        load_affine(a.in[5] + 2 * D, mb + 6144 + 1024, mb + 6144, X.lane, Aq, Bq);
        for (int tp = 0; tp < 8; tp += 2) {
            f32x4 gt[2], xv[2][4]; u32x2 yw[2][4][4];
#pragma unroll
            for (int q = 0; q < 2; ++q) { const int t = t0 + tp + q; gt[q] = *(const f32x4*)(RGATE + (size_t)t * 4);
#pragma unroll
                for (int j = 0; j < 4; ++j) { const int d = 4 * X.lane + 256 * j; xv[q][j] = *(const f32x4*)(X1 + (size_t)t * D + d);
#pragma unroll
                    for (int k = 0; k < 4; ++k) yw[q][j][k] = *(const u32x2*)(YS + ((size_t)t * 4 + k) * 1024 + d); } }
#pragma unroll
            for (int q = 0; q < 2; ++q) { const int t = t0 + tp + q;
                f32x4 v[4];
#pragma unroll
                for (int j = 0; j < 4; ++j) { const int d = 4 * X.lane + 256 * j; f32x4 s = (f32x4){0.f, 0.f, 0.f, 0.f};
#pragma unroll
                    for (int k = 0; k < 4; ++k) { const u32x2 w = yw[q][j][k]; const float g = gt[q][k];
                        s[0] += g * bflo(w.x); s[1] += g * bfhi(w.x); s[2] += g * bflo(w.y); s[3] += g * bfhi(w.y); }
                    v[j] = xv[q][j] + G2[j] * s; *(f32x4*)(X2 + (size_t)t * D + d) = v[j]; }
                const float r = row_rs(v);
                f32x4 h[4];
#pragma unroll
                for (int j = 0; j < 4; ++j) h[j] = v[j] * r * Ak[j] + Bk[j];
                store_bf16_row(HKV + (size_t)t * D, X.lane, h);
#pragma unroll
                for (int j = 0; j < 4; ++j) h[j] = v[j] * r * Aq[j] + Bq[j];
                store_bf16_row(HQ + (size_t)t * D, X.lane, h); }
        }
    }
}
DI void p18_final(const Ctx& X, const Args& a) {
    const float* MOD = (const float*)(X.ws + WS_MOD); const float* X3 = (const float*)(X.ws + WS_X1);
    const bf16* YS = (const bf16*)(X.ws + WS_YS); const float* RGATE = (const float*)(X.ws + WS_RGATE);
    for (int tb = X.gw; tb < T / 8; tb += X.NGW) {
        const int t0 = tb * 8, b = t0 / SEQ; const float* mb = MOD + (size_t)b * MODW + 6144;
        f32x4 G2[4];
#pragma unroll
        for (int j = 0; j < 4; ++j) G2[j] = *(const f32x4*)(mb + 5120 + 4 * X.lane + 256 * j);
        for (int tp = 0; tp < 8; tp += 2) {
            f32x4 gt[2], xv[2][4]; u32x2 yw[2][4][4];
#pragma unroll
            for (int q = 0; q < 2; ++q) { const int t = t0 + tp + q; gt[q] = *(const f32x4*)(RGATE + (size_t)t * 4);
#pragma unroll
                for (int j = 0; j < 4; ++j) { const int d = 4 * X.lane + 256 * j; xv[q][j] = *(const f32x4*)(X3 + (size_t)t * D + d);
#pragma unroll
                    for (int k = 0; k < 4; ++k) yw[q][j][k] = *(const u32x2*)(YS + ((size_t)t * 4 + k) * 1024 + d); } }
#pragma unroll
            for (int q = 0; q < 2; ++q) { const int t = t0 + tp + q;
#pragma unroll
                for (int j = 0; j < 4; ++j) { const int d = 4 * X.lane + 256 * j; f32x4 s = (f32x4){0.f, 0.f, 0.f, 0.f};
#pragma unroll
                    for (int k = 0; k < 4; ++k) { const u32x2 w = yw[q][j][k]; const float g = gt[q][k];
                        s[0] += g * bflo(w.x); s[1] += g * bfhi(w.x); s[2] += g * bflo(w.y); s[3] += g * bfhi(w.y); }
                    *(f32x4*)(a.out + (size_t)t * D + d) = xv[q][j] + G2[j] * s; } }
        }
    }
}

DI void unpack16(const u32x4 a, const u32x4 b, float (&f)[16]) {
    f[0] = bflo(a.x); f[1] = bfhi(a.x); f[2] = bflo(a.y); f[3] = bfhi(a.y); f[4] = bflo(a.z); f[5] = bfhi(a.z); f[6] = bflo(a.w); f[7] = bfhi(a.w);
    f[8] = bflo(b.x); f[9] = bfhi(b.x); f[10] = bflo(b.y); f[11] = bfhi(b.y); f[12] = bflo(b.z); f[13] = bfhi(b.z); f[14] = bflo(b.w); f[15] = bfhi(b.w);
}
DI void store16(bf16* p, const float (&f)[16]) {
    u32x4 a, b; a.x = pk2(f[0], f[1]); a.y = pk2(f[2], f[3]); a.z = pk2(f[4], f[5]); a.w = pk2(f[6], f[7]); b.x = pk2(f[8], f[9]); b.y = pk2(f[10], f[11]); b.z = pk2(f[12], f[13]); b.w = pk2(f[14], f[15]);
    *(u32x4*)p = a; *(u32x4*)(p + 8) = b;
}
DI void p5_onorm(const Ctx& X, const Args& a) {
    const bf16* O = (const bf16*)(X.ws + WS_O); const bf16* PROJ = (const bf16*)(X.ws + WS_PROJ); bf16* ON = (bf16*)(X.ws + WS_ON);
    float og[16];
#pragma unroll
    for (int i = 0; i < 16; ++i) og[i] = a.in[10][(16 * X.lane + i) & 127];
    for (int tb = X.gw; tb < T / 4; tb += X.NGW) {
        u32x4 ov[4][2], zv[4][2];
#pragma unroll
        for (int tt = 0; tt < 4; ++tt) { const size_t t = (size_t)tb * 4 + tt;
            ov[tt][0] = *(const u32x4*)(O + t * D + 16 * X.lane); ov[tt][1] = *(const u32x4*)(O + t * D + 16 * X.lane + 8);
            zv[tt][0] = *(const u32x4*)(PROJ + t * 4096 + 3072 + 16 * X.lane); zv[tt][1] = *(const u32x4*)(PROJ + t * 4096 + 3072 + 16 * X.lane + 8); }
#pragma unroll
        for (int tt = 0; tt < 4; ++tt) { const size_t t = (size_t)tb * 4 + tt;
            float o[16], z[16]; unpack16(ov[tt][0], ov[tt][1], o); unpack16(zv[tt][0], zv[tt][1], z);
            float ss = 0.f;
#pragma unroll
            for (int i = 0; i < 16; ++i) ss += o[i] * o[i];
            ss += __shfl_xor(ss, 1); ss += __shfl_xor(ss, 2); ss += __shfl_xor(ss, 4);
            const float r = rsqrtf(ss * (1.0f / 128.0f) + EPS);
#pragma unroll
            for (int i = 0; i < 16; ++i) o[i] = o[i] * r * og[i] * siluf_(z[i]);
            store16(ON + t * D + 16 * X.lane, o); }
    }
}

DI void p12_qknorm(const Ctx& X, const Args& a) {
    const bf16* QKV = (const bf16*)(X.ws + WS_QKV); const float* ROPE = (const float*)(X.ws + WS_ROPE);
    bf16* QN = (bf16*)(X.ws + WS_QN); bf16* KN = (bf16*)(X.ws + WS_KN); bf16* VT = (bf16*)(X.ws + WS_VT);
    float qg[16], kg[16];
#pragma unroll
    for (int i = 0; i < 16; ++i) { qg[i] = a.in[18][(16 * X.lane + i) & 63]; kg[i] = a.in[16][(16 * X.lane + i) & 63]; }
    for (int t = X.gw; t < T; t += X.NGW) {
        const int b = t / SEQ, s = t % SEQ;
        float cs[8], sn[8];
        { const f32x4 c0 = *(const f32x4*)(ROPE + (size_t)t * 16), c1 = *(const f32x4*)(ROPE + (size_t)t * 16 + 4), s0 = *(const f32x4*)(ROPE + (size_t)t * 16 + 8), s1 = *(const f32x4*)(ROPE + (size_t)t * 16 + 12);
#pragma unroll
          for (int i = 0; i < 4; ++i) { cs[i] = c0[i]; cs[4 + i] = c1[i]; sn[i] = s0[i]; sn[4 + i] = s1[i]; } }
        float q[16];
        unpack16(*(const u32x4*)(QKV + (size_t)t * 1280 + 256 + 16 * X.lane), *(const u32x4*)(QKV + (size_t)t * 1280 + 256 + 16 * X.lane + 8), q);
        float ss = 0.f;
#pragma unroll
        for (int i = 0; i < 16; ++i) ss += q[i] * q[i];
        ss += __shfl_xor(ss, 1); ss += __shfl_xor(ss, 2);
        float r = rsqrtf(ss * (1.0f / 64.0f) + EPS);
#pragma unroll
        for (int i = 0; i < 16; ++i) q[i] = q[i] * r * qg[i];
        if ((X.lane & 3) == 0) {
#pragma unroll
            for (int i = 0; i < 8; ++i) { const float x1 = q[i], x2 = q[8 + i]; q[i] = x1 * cs[i] - x2 * sn[i]; q[8 + i] = x2 * cs[i] + x1 * sn[i]; } }
#pragma unroll
        for (int i = 0; i < 16; ++i) q[i] *= 0.125f;
        store16(QN + (size_t)t * D + 16 * X.lane, q);
        if (X.lane < 8) {
            float k[16], v[16];
            unpack16(*(const u32x4*)(QKV + (size_t)t * 1280 + 16 * X.lane), *(const u32x4*)(QKV + (size_t)t * 1280 + 16 * X.lane + 8), k);
            unpack16(*(const u32x4*)(QKV + (size_t)t * 1280 + 128 + 16 * X.lane), *(const u32x4*)(QKV + (size_t)t * 1280 + 128 + 16 * X.lane + 8), v);
            float s2 = 0.f;
#pragma unroll
            for (int i = 0; i < 16; ++i) s2 += k[i] * k[i];
            s2 += __shfl_xor(s2, 1); s2 += __shfl_xor(s2, 2);
            r = rsqrtf(s2 * (1.0f / 64.0f) + EPS);
#pragma unroll
            for (int i = 0; i < 16; ++i) k[i] = k[i] * r * kg[i];
            if ((X.lane & 3) == 0) {
#pragma unroll
                for (int i = 0; i < 8; ++i) { const float x1 = k[i], x2 = k[8 + i]; k[i] = x1 * cs[i] - x2 * sn[i]; k[8 + i] = x2 * cs[i] + x1 * sn[i]; } }
            const int kvh = X.lane >> 2, d0 = (16 * X.lane) & 63;
            store16(KN + ((size_t)(b * 2 + kvh) * SEQ + s) * 64 + d0, k);
#pragma unroll
            for (int i = 0; i < 16; ++i) VT[((size_t)(b * 2 + kvh) * 64 + d0 + i) * SEQ + s] = (bf16)f2bf(v[i]);
        }
    }
}

#define MFMA4F(a, b, c) __builtin_amdgcn_mfma_f32_16x16x4f32((a), (b), (c), 0, 0, 0)
constexpr int P3_QB = 0, P3_KB = 17408, P3_RT = 34816, P3_AF = 71680, P3_TF = 89088, P3_WS = 106496, P3_TB = 123904, P3_GC = 133120;
DI f32x4 blk_mm(f32x4 acc, const LAS float* Xm, int xr0, int xc0, const LAS float* Ym, int yr0, int yc0, int fr, int fq) {
#pragma unroll
    for (int s = 0; s < 4; ++s) acc = MFMA4F(Xm[(xr0 + fr) * 68 + xc0 + 4 * s + fq], Ym[(yr0 + 4 * s + fq) * 68 + yc0 + fr], acc);
    return acc;
}
DI void blk_st(LAS float* M, int r0, int c0, const f32x4 acc, float sgn, int fr, int fq) {
#pragma unroll
    for (int r = 0; r < 4; ++r) M[(r0 + 4 * fq + r) * 68 + c0 + fr] = sgn * acc[r];
}
DI void blk_st_tb(LAS float* TF, LAS bf16* TB, int r0, int c0, const f32x4 acc, int fr, int fq) {
#pragma unroll
    for (int r = 0; r < 4; ++r) { TF[(r0 + 4 * fq + r) * 68 + c0 + fr] = -acc[r]; TB[(r0 + 4 * fq + r) * 72 + c0 + fr] = (bf16)f2bf(-acc[r]); }
}
DI u32x4 pack8(const float (&f)[8]) { u32x4 w; w.x = pk2(f[0], f[1]); w.y = pk2(f[2], f[3]); w.z = pk2(f[4], f[5]); w.w = pk2(f[6], f[7]); return w; }
DI void p3_prep(const Ctx& X, const Args& a) {
    LAS bf16* QB = (LAS bf16*)(X.lds + P3_QB); LAS bf16* KBb = (LAS bf16*)(X.lds + P3_KB); LAS bf16* RT = (LAS bf16*)(X.lds + P3_RT);
    LAS float* AF = (LAS float*)(X.lds + P3_AF); LAS float* TF = (LAS float*)(X.lds + P3_TF); LAS float* WSm = (LAS float*)(X.lds + P3_WS);
    LAS bf16* TB = (LAS bf16*)(X.lds + P3_TB);
    LAS float* GC = (LAS float*)(X.lds + P3_GC); LAS float* BETA = GC + 64; LAS float* EG = GC + 128;
    const bf16* PROJ = (const bf16*)(X.ws + WS_PROJ); const float* AB = (const float*)(X.ws + WS_AB);
    float* UT = (float*)(X.ws + WS_UT); bf16* WNEG = (bf16*)(X.ws + WS_WNEG); bf16* QD = (bf16*)(X.ws + WS_QD); bf16* KTT = (bf16*)(X.ws + WS_KTT); bf16* QKG = (bf16*)(X.ws + WS_QK);
    float* GTOT = (float*)(X.ws + WS_GTOT);
    const float* convw = a.in[7];
    const int fr_ = X.lane & 15, fq_ = X.lane >> 4;
    for (int idx = X.tid; idx < 64 * 72 / 2; idx += NTHR) ((LAS unsigned*)TB)[idx] = 0u;
    BAR_LDS();
    u32x4 xr[11]; f32x4 cw[4][2]; float avn = 0.f, bvn = 0.f;
#define P3_LOAD(cid_) do { const int c_ = (cid_); const int b_ = c_ >> 8, h_ = (c_ >> 5) & 7, n_ = c_ & 31, t0_ = b_ * SEQ + n_ * 64; \
        int fr__ = fr_, fq__ = fq_; asm volatile("" : "+v"(fr__), "+v"(fq__)); \
        if (X.wave < 6) { const int which_ = X.wave >> 1, rs_ = (X.wave & 1) * 4 + fq__, ch0_ = which_ * 1024 + h_ * 128 + 8 * fr__; \
            const bf16* src_ = PROJ + ((ptrdiff_t)t0_ + 8 * rs_ - 3) * 4096 + ch0_; \
            _Pragma("unroll") for (int m = 0; m < 11; ++m) { const bool valid_ = (n_ > 0) || (8 * rs_ - 3 + m >= 0); xr[m] = (u32x4){0u, 0u, 0u, 0u}; if (valid_) xr[m] = *(const u32x4*)(src_ + (ptrdiff_t)m * 4096); } \
            _Pragma("unroll") for (int i = 0; i < 4; ++i) { cw[i][0] = *(const f32x4*)(convw + i * 3072 + ch0_); cw[i][1] = *(const f32x4*)(convw + i * 3072 + ch0_ + 4); } \
        } else if (X.wave == 6) { const int i_ = fq__ * 16 + fr__; avn = AB[(size_t)(t0_ + i_) * 16 + h_]; bvn = AB[(size_t)(t0_ + i_) * 16 + 8 + h_]; } } while (0)
    if (X.vcu < NB * AH * NCH) P3_LOAD(X.vcu);
    for (int cid = X.vcu; cid < NB * AH * NCH; cid += X.G) {
        int fr = fr_, fq = fq_; asm volatile("" : "+v"(fr), "+v"(fq));
        const int b = cid >> 8, h = (cid >> 5) & 7, n = cid & 31, t0 = b * SEQ + n * 64;
        const size_t rowbase = (size_t)(b * 8 + h) * SEQ + n * 64;
        const int which = X.wave >> 1, rs = (X.wave & 1) * 4 + fq, cg = fr;
        if (X.wave == 6) {
            const int i = fq * 16 + fr;
            const float xx = avn + a.in[9][h]; const float sp = xx > 20.f ? xx : log1pf(__expf(xx));
            float g = -__expf(a.in[8][h]) * sp;
#pragma unroll
            for (int o = 1; o < 64; o <<= 1) { const float up = __shfl_up(g, o); if (i >= o) g += up; }
            GC[i] = g; BETA[i] = sigmoidf_(bvn); EG[i] = __expf(g);
            if (i == 63) GTOT[cid] = __expf(g);
        }
        BAR_LDS();
        if (X.wave < 6) {
            float y[8][8];
#pragma unroll
            for (int ch = 0; ch < 8; ++ch) { float xc[11];
#pragma unroll
                for (int m = 0; m < 11; ++m) { const unsigned wv = xr[m][ch >> 1]; xc[m] = (ch & 1) ? bfhi(wv) : bflo(wv); }
                const float w0 = cw[0][ch >> 2][ch & 3], w1 = cw[1][ch >> 2][ch & 3], w2 = cw[2][ch >> 2][ch & 3], w3 = cw[3][ch >> 2][ch & 3];
#pragma unroll
                for (int rr = 0; rr < 8; ++rr) y[rr][ch] = silu_fast(w0 * xc[rr] + w1 * xc[rr + 1] + w2 * xc[rr + 2] + w3 * xc[rr + 3]); }
            float be[8], eg[8], gcr[8];
#pragma unroll
            for (int rr = 0; rr < 8; ++rr) { be[rr] = BETA[8 * rs + rr]; eg[rr] = EG[8 * rs + rr]; gcr[rr] = GC[8 * rs + rr]; }
            if (which < 2) {
#pragma unroll
                for (int rr = 0; rr < 8; ++rr) { float ss = 0.f;
#pragma unroll
                    for (int ch = 0; ch < 8; ++ch) ss += y[rr][ch] * y[rr][ch];
                    ss += __shfl_xor(ss, 1); ss += __shfl_xor(ss, 2); ss += __shfl_xor(ss, 4); ss += __shfl_xor(ss, 8);
                    const float r = rsqrtf(ss + EPS) * (which == 0 ? 0.08838834764831845f : 1.0f);
#pragma unroll
                    for (int ch = 0; ch < 8; ++ch) y[rr][ch] *= r; }
            }
            if (which == 0) {
#pragma unroll
                for (int rr = 0; rr < 8; ++rr) { *(LAS u32x4*)(QB + (8 * rs + rr) * 136 + 8 * cg) = pack8(y[rr]);
                    float s[8];
#pragma unroll
                    for (int ch = 0; ch < 8; ++ch) s[ch] = y[rr][ch] * eg[rr];
                    *(u32x4*)(QD + (rowbase + 8 * rs + rr) * 128 + 8 * cg) = pack8(s); }
            } else if (which == 1) {
                const float gl = GC[63];
                float tail[8];
#pragma unroll
                for (int rr = 0; rr < 8; ++rr) { *(LAS u32x4*)(KBb + (8 * rs + rr) * 136 + 8 * cg) = pack8(y[rr]); tail[rr] = __expf(gl - gcr[rr]); }
#pragma unroll
                for (int ch = 0; ch < 8; ++ch) { float s[8], u[8];
#pragma unroll
                    for (int rr = 0; rr < 8; ++rr) { s[rr] = y[rr][ch] * be[rr] * eg[rr]; u[rr] = y[rr][ch] * tail[rr]; }
                    *(LAS u32x4*)(RT + (128 + 8 * cg + ch) * 72 + 8 * rs) = pack8(s);
                    *(u32x4*)(KTT + (size_t)cid * 8192 + (8 * cg + ch) * 64 + 8 * rs) = pack8(u); }
            } else {
#pragma unroll
                for (int ch = 0; ch < 8; ++ch) { float s[8];
#pragma unroll
                    for (int rr = 0; rr < 8; ++rr) s[rr] = y[rr][ch] * be[rr];
                    *(LAS u32x4*)(RT + (8 * cg + ch) * 72 + 8 * rs) = pack8(s); }
            }
        }
        if (cid + X.G < NB * AH * NCH) P3_LOAD(cid + X.G);
        BAR_LDS();
        if (X.wave == 0) {
#pragma unroll
            for (int ab = 0; ab < 10; ++ab) { const int ta = ab < 1 ? 0 : ab < 3 ? 1 : ab < 6 ? 2 : 3, tb = ab - (ta * (ta + 1)) / 2;
                f32x4 acc = (f32x4){0.f, 0.f, 0.f, 0.f};
#pragma unroll
                for (int kk = 0; kk < 4; ++kk) acc = MFMA16(*(const LAS bf16x8*)(KBb + (16 * ta + fr) * 136 + kk * 32 + fq * 8), *(const LAS bf16x8*)(KBb + (16 * tb + fr) * 136 + kk * 32 + fq * 8), acc);
                const int j = 16 * tb + fr; const float gj = GC[j];
#pragma unroll
                for (int r = 0; r < 4; ++r) { const int i = 16 * ta + 4 * fq + r; AF[i * 68 + j] = (i > j) ? acc[r] * BETA[i] * __expf(fminf(GC[i] - gj, 0.f)) : 0.f; } }
            asm volatile("s_waitcnt lgkmcnt(0)" ::: "memory");
            {
                const int kb = fq, c = fr; float t[16];
#pragma unroll
                for (int ii = 0; ii < 16; ++ii) { const LAS float* ar = AF + (16 * kb + ii) * 68 + 16 * kb;
                    float av[16];
#pragma unroll
                    for (int q = 0; q < 4; ++q) { const f32x4 v4 = *(const LAS f32x4*)(ar + 4 * q); av[4 * q] = v4[0]; av[4 * q + 1] = v4[1]; av[4 * q + 2] = v4[2]; av[4 * q + 3] = v4[3]; }
                    float s = (ii == c) ? 1.f : 0.f;
#pragma unroll
                    for (int jj = 0; jj < ii; ++jj) s -= av[jj] * t[jj];
                    t[ii] = s; }
#pragma unroll
                for (int ii = 0; ii < 16; ++ii) { TF[(16 * kb + ii) * 68 + 16 * kb + c] = t[ii]; TB[(16 * kb + ii) * 72 + 16 * kb + c] = (bf16)f2bf(t[ii]); }
            }
            asm volatile("s_waitcnt lgkmcnt(0)" ::: "memory");
            const f32x4 z4 = (f32x4){0.f, 0.f, 0.f, 0.f};
            { const f32x4 w10 = blk_mm(z4, AF, 16, 0, TF, 0, 0, fr, fq), w32 = blk_mm(z4, AF, 48, 32, TF, 32, 32, fr, fq);
              blk_st(WSm, 16, 0, w10, 1.f, fr, fq); blk_st(WSm, 48, 32, w32, 1.f, fr, fq); }
            asm volatile("s_waitcnt lgkmcnt(0)" ::: "memory");
            { const f32x4 t10 = blk_mm(z4, TF, 16, 16, WSm, 16, 0, fr, fq), t32 = blk_mm(z4, TF, 48, 48, WSm, 48, 32, fr, fq);
              blk_st_tb(TF, TB, 16, 0, t10, fr, fq); blk_st_tb(TF, TB, 48, 32, t32, fr, fq); }
            asm volatile("s_waitcnt lgkmcnt(0)" ::: "memory");
            { f32x4 w20 = blk_mm(z4, AF, 32, 0, TF, 0, 0, fr, fq); w20 = blk_mm(w20, AF, 32, 16, TF, 16, 0, fr, fq);
              f32x4 w30 = blk_mm(z4, AF, 48, 0, TF, 0, 0, fr, fq); w30 = blk_mm(w30, AF, 48, 16, TF, 16, 0, fr, fq);
              const f32x4 w21 = blk_mm(z4, AF, 32, 16, TF, 16, 16, fr, fq), w31 = blk_mm(z4, AF, 48, 16, TF, 16, 16, fr, fq);
              blk_st(WSm, 32, 0, w20, 1.f, fr, fq); blk_st(WSm, 48, 0, w30, 1.f, fr, fq); blk_st(WSm, 32, 16, w21, 1.f, fr, fq); blk_st(WSm, 48, 16, w31, 1.f, fr, fq); }
            asm volatile("s_waitcnt lgkmcnt(0)" ::: "memory");
            { const f32x4 t20 = blk_mm(z4, TF, 32, 32, WSm, 32, 0, fr, fq), t21 = blk_mm(z4, TF, 32, 32, WSm, 32, 16, fr, fq);
              f32x4 t30 = blk_mm(z4, TF, 48, 32, WSm, 32, 0, fr, fq); t30 = blk_mm(t30, TF, 48, 48, WSm, 48, 0, fr, fq);
              f32x4 t31 = blk_mm(z4, TF, 48, 32, WSm, 32, 16, fr, fq); t31 = blk_mm(t31, TF, 48, 48, WSm, 48, 16, fr, fq);
              blk_st_tb(TF, TB, 32, 0, t20, fr, fq); blk_st_tb(TF, TB, 32, 16, t21, fr, fq); blk_st_tb(TF, TB, 48, 0, t30, fr, fq); blk_st_tb(TF, TB, 48, 16, t31, fr, fq); }
        } else {
            for (int tt = X.wave - 1; tt < 16; tt += 7) { const int it = tt >> 2, jt = tt & 3;
                f32x4 acc = (f32x4){0.f, 0.f, 0.f, 0.f};
                if (it >= jt) {
#pragma unroll
                    for (int kk = 0; kk < 4; ++kk) acc = MFMA16(*(const LAS bf16x8*)(KBb + (16 * jt + fr) * 136 + kk * 32 + fq * 8), *(const LAS bf16x8*)(QB + (16 * it + fr) * 136 + kk * 32 + fq * 8), acc);
                }
                const int i = 16 * it + fr; const float gi = GC[i]; float v[4];
#pragma unroll
                for (int r = 0; r < 4; ++r) { const int j = 16 * jt + 4 * fq + r; v[r] = (j <= i) ? acc[r] * __expf(fminf(gi - GC[j], 0.f)) : 0.f; }
                u32x2 p; p.x = pk2(v[0], v[1]); p.y = pk2(v[2], v[3]);
                *(u32x2*)(QKG + (size_t)cid * 4096 + i * 64 + 16 * jt + 4 * fq) = p; }
        }
        BAR_LDS();
        {
            const int half = X.wave >> 2, it = X.wave & 3, ns = it < 2 ? 1 : 2;
            bf16x8 tf[2];
#pragma unroll
            for (int s = 0; s < 2; ++s) tf[s] = *(const LAS bf16x8*)(TB + (16 * it + fr) * 72 + 32 * (s < ns ? s : 0) + 8 * fq);
#pragma unroll
            for (int ct = 0; ct < 8; ++ct) { const int c0 = half * 128 + 16 * ct;
                f32x4 acc = (f32x4){0.f, 0.f, 0.f, 0.f};
                if (half == 0) {
#pragma unroll
                    for (int s = 0; s < 2; ++s) if (s < ns) acc = MFMA16(tf[s], *(const LAS bf16x8*)(RT + (c0 + fr) * 72 + 32 * s + 8 * fq), acc);
                    *(f32x4*)(UT + (size_t)cid * 8192 + (c0 + fr) * 64 + 16 * it + 4 * fq) = acc;
                } else {
#pragma unroll
                    for (int s = 0; s < 2; ++s) if (s < ns) acc = MFMA16(*(const LAS bf16x8*)(RT + (c0 + fr) * 72 + 32 * s + 8 * fq), tf[s], acc);
                    u32x2 p; p.x = pk2(-acc[0], -acc[1]); p.y = pk2(-acc[2], -acc[3]);
                    *(u32x2*)(WNEG + (rowbase + 16 * it + fr) * 128 + (c0 - 128) + 4 * fq) = p; }
            }
        }
        BAR_LDS();
    }
#undef P3_LOAD
}

struct ScanFrag { bf16x8 wn[4], qd[4], qk[2], kt[2]; f32x4 u; float gt; };
DI ScanFrag scan_load(const float* UT, const bf16* WNEG, const bf16* QD, const bf16* KTT, const bf16* QKG, const float* GTOT, int bh, int n, int sl, int w, int et, int jt, int fr, int fq) {
    ScanFrag f; const int cid = bh * 32 + n; const size_t rowbase = (size_t)bh * SEQ + n * 64;
#pragma unroll
    for (int kk = 0; kk < 4; ++kk) { f.wn[kk] = *(const bf16x8*)(WNEG + (rowbase + 16 * jt + fr) * 128 + kk * 32 + fq * 8); f.qd[kk] = *(const bf16x8*)(QD + (rowbase + 16 * jt + fr) * 128 + kk * 32 + fq * 8); }
#pragma unroll
    for (int k2 = 0; k2 < 2; ++k2) { f.qk[k2] = *(const bf16x8*)(QKG + (size_t)cid * 4096 + (16 * jt + fr) * 64 + k2 * 32 + fq * 8); f.kt[k2] = *(const bf16x8*)(KTT + (size_t)cid * 8192 + (16 * w + fr) * 64 + k2 * 32 + fq * 8); }
    f.u = *(const f32x4*)(UT + (size_t)cid * 8192 + (sl * 32 + 16 * et + fr) * 64 + 16 * jt + 4 * fq);
    f.gt = GTOT[cid];
    return f;
}
DI void scan_step(const ScanFrag& cur, f32x4& S0, f32x4& S1, LAS bf16* SL, LAS bf16* VL, bf16* orow, int w, int et, int jt, int fr, int fq) {
    f32x4 v = cur.u;
    { u32x2 p0, p1; p0.x = pk2(S0[0], S0[1]); p0.y = pk2(S0[2], S0[3]); p1.x = pk2(S1[0], S1[1]); p1.y = pk2(S1[2], S1[3]);
      *(LAS u32x2*)(SL + fr * 136 + 16 * w + 4 * fq) = p0; *(LAS u32x2*)(SL + (16 + fr) * 136 + 16 * w + 4 * fq) = p1; }
    BAR_LDS();
    f32x4 o = (f32x4){0.f, 0.f, 0.f, 0.f};
#pragma unroll
    for (int kk = 0; kk < 4; ++kk) { const bf16x8 sf = *(const LAS bf16x8*)(SL + (16 * et + fr) * 136 + kk * 32 + fq * 8);
        v = MFMA16(cur.wn[kk], sf, v); o = MFMA16(sf, cur.qd[kk], o); }
    { u32x2 p; p.x = pk2(v[0], v[1]); p.y = pk2(v[2], v[3]); *(LAS u32x2*)(VL + (16 * et + fr) * 72 + 16 * jt + 4 * fq) = p; }
    BAR_LDS();
#pragma unroll
    for (int r = 0; r < 4; ++r) { S0[r] *= cur.gt; S1[r] *= cur.gt; }
#pragma unroll
    for (int k2 = 0; k2 < 2; ++k2) { const bf16x8 v0 = *(const LAS bf16x8*)(VL + fr * 72 + k2 * 32 + fq * 8), v1 = *(const LAS bf16x8*)(VL + (16 + fr) * 72 + k2 * 32 + fq * 8);
        o = MFMA16(et ? v1 : v0, cur.qk[k2], o); S0 = MFMA16(cur.kt[k2], v0, S0); S1 = MFMA16(cur.kt[k2], v1, S1); }
    { u32x2 p; p.x = pk2(o[0], o[1]); p.y = pk2(o[2], o[3]); *(u32x2*)orow = p; }
}
DI void p4_scan(const Ctx& X, const Args& a) {
    LAS bf16* SL = (LAS bf16*)X.lds;
    LAS bf16* VL = (LAS bf16*)(X.lds + 32 * 136 * 2);
    const float* UT = (const float*)(X.ws + WS_UT); const bf16* WNEG = (const bf16*)(X.ws + WS_WNEG); const bf16* QD = (const bf16*)(X.ws + WS_QD);
    const bf16* KTT = (const bf16*)(X.ws + WS_KTT); const bf16* QKG = (const bf16*)(X.ws + WS_QK); const float* GTOT = (const float*)(X.ws + WS_GTOT);
    bf16* O = (bf16*)(X.ws + WS_O);
    const int fr = X.lane & 15, fq = X.lane >> 4, w = X.wave, et = w & 1, jt = w >> 1;
    for (int unit = X.vcu; unit < NB * AH * 4; unit += X.G) {
        const int bh = unit >> 2, sl = unit & 3, b = bh >> 3, h = bh & 7;
        f32x4 S0 = (f32x4){0.f, 0.f, 0.f, 0.f}, S1 = S0;
        bf16* obase = O + (size_t)(b * SEQ + 16 * jt + fr) * D + h * 128 + sl * 32 + 16 * et + 4 * fq;
#define SCAN_LOAD(n_) scan_load(UT, WNEG, QD, KTT, QKG, GTOT, bh, (n_) < NCH ? (n_) : NCH - 1, sl, w, et, jt, fr, fq)
        ScanFrag fa = SCAN_LOAD(0), fb = SCAN_LOAD(1), fc;
        for (int n = 0; n < NCH; n += 3) {
            fc = SCAN_LOAD(n + 2); scan_step(fa, S0, S1, SL, VL, obase + (size_t)n * 64 * D, w, et, jt, fr, fq);
            if (n + 1 >= NCH) break;
            fa = SCAN_LOAD(n + 3); scan_step(fb, S0, S1, SL, VL, obase + (size_t)(n + 1) * 64 * D, w, et, jt, fr, fq);
            if (n + 2 >= NCH) break;
            fb = SCAN_LOAD(n + 4); scan_step(fc, S0, S1, SL, VL, obase + (size_t)(n + 2) * 64 * D, w, et, jt, fr, fq);
        }
#undef SCAN_LOAD
        BAR_LDS();
    }
}

DI void p13_attn(const Ctx& X, const Args& a) {
    LAS bf16* KL = (LAS bf16*)X.lds;
    LAS bf16* VTL = (LAS bf16*)(X.lds + 256 * 72 * 2);
    const bf16* QKV = (const bf16*)(X.ws + WS_QKV); const float* ROPE = (const float*)(X.ws + WS_ROPE);
    bf16* O = (bf16*)(X.ws + WS_O);
    const int fr = X.lane & 15, fq = X.lane >> 4, c8 = X.tid & 7;
    float kg[8], qg[2][8];
#pragma unroll
    for (int i = 0; i < 8; ++i) { kg[i] = a.in[16][c8 * 8 + i]; qg[0][i] = a.in[18][fq * 8 + i]; qg[1][i] = a.in[18][32 + fq * 8 + i]; }
    for (int unit = X.vcu; unit < NB * 2 * 16; unit += X.G) {
        const int b = unit >> 5, kvh = (unit >> 4) & 1, blk = unit & 15, s0 = blk * 128;
        BAR_LDS();
#pragma unroll
        for (int it = 0; it < 4; ++it) { const int key = (X.tid >> 3) + 64 * it; const int s = s0 - 128 + key; const size_t t = (size_t)b * SEQ + (s >= 0 ? s : 0);
            u32x4 kr = (u32x4){0u, 0u, 0u, 0u}, vr = kr; f32x4 c0 = (f32x4){0.f, 0.f, 0.f, 0.f}, c1 = c0, n0 = c0, n1 = c0;
            if (s >= 0) { kr = *(const u32x4*)(QKV + t * 1280 + kvh * 64 + c8 * 8); vr = *(const u32x4*)(QKV + t * 1280 + 128 + kvh * 64 + c8 * 8);
                if (c8 < 2) { c0 = *(const f32x4*)(ROPE + t * 16); c1 = *(const f32x4*)(ROPE + t * 16 + 4); n0 = *(const f32x4*)(ROPE + t * 16 + 8); n1 = *(const f32x4*)(ROPE + t * 16 + 12); } }
            float f[8] = {bflo(kr.x), bfhi(kr.x), bflo(kr.y), bfhi(kr.y), bflo(kr.z), bfhi(kr.z), bflo(kr.w), bfhi(kr.w)};
            float ss = 0.f;
#pragma unroll
            for (int i = 0; i < 8; ++i) ss += f[i] * f[i];
            ss += __shfl_xor(ss, 1); ss += __shfl_xor(ss, 2); ss += __shfl_xor(ss, 4);
            const float r = rsqrtf(ss * (1.0f / 64.0f) + EPS);
            const float cs[8] = {c0[0], c0[1], c0[2], c0[3], c1[0], c1[1], c1[2], c1[3]}, sn[8] = {n0[0], n0[1], n0[2], n0[3], n1[0], n1[1], n1[2], n1[3]};
#pragma unroll
            for (int i = 0; i < 8; ++i) { f[i] = f[i] * r * kg[i]; const float p = __shfl_xor(f[i], 1);
                if (c8 == 0) f[i] = f[i] * cs[i] - p * sn[i]; else if (c8 == 1) f[i] = f[i] * cs[i] + p * sn[i]; }
            *(LAS u32x4*)(KL + key * 72 + c8 * 8) = pack8(f);
            const unsigned vw[4] = {vr.x, vr.y, vr.z, vr.w};
#pragma unroll
            for (int i = 0; i < 8; ++i) VTL[(c8 * 8 + i) * 264 + key] = (bf16)((i & 1) ? (vw[i >> 1] >> 16) : (vw[i >> 1] & 0xffffu)); }
        BAR_LDS();
        const int head = kvh * 8 + X.wave; const float sink = a.in[19][head];
        for (int qt = 0; qt < 8; ++qt) {
            const int tq = b * SEQ + s0 + 16 * qt + fr;
            bf16x8 qf[2];
            { const u32x4 r0 = *(const u32x4*)(QKV + (size_t)tq * 1280 + 256 + head * 64 + fq * 8), r1 = *(const u32x4*)(QKV + (size_t)tq * 1280 + 256 + head * 64 + 32 + fq * 8);
              f32x4 c0 = (f32x4){0.f, 0.f, 0.f, 0.f}, c1 = c0, n0 = c0, n1 = c0;
              if (fq < 2) { c0 = *(const f32x4*)(ROPE + (size_t)tq * 16); c1 = *(const f32x4*)(ROPE + (size_t)tq * 16 + 4); n0 = *(const f32x4*)(ROPE + (size_t)tq * 16 + 8); n1 = *(const f32x4*)(ROPE + (size_t)tq * 16 + 12); }
              float f0[8] = {bflo(r0.x), bfhi(r0.x), bflo(r0.y), bfhi(r0.y), bflo(r0.z), bfhi(r0.z), bflo(r0.w), bfhi(r0.w)};
              float f1[8] = {bflo(r1.x), bfhi(r1.x), bflo(r1.y), bfhi(r1.y), bflo(r1.z), bfhi(r1.z), bflo(r1.w), bfhi(r1.w)};
              float ss = 0.f;
#pragma unroll
              for (int i = 0; i < 8; ++i) ss += f0[i] * f0[i] + f1[i] * f1[i];
              ss += __shfl_xor(ss, 16); ss += __shfl_xor(ss, 32);
              const float r = rsqrtf(ss * (1.0f / 64.0f) + EPS) * 0.125f;
              const float cs[8] = {c0[0], c0[1], c0[2], c0[3], c1[0], c1[1], c1[2], c1[3]}, sn[8] = {n0[0], n0[1], n0[2], n0[3], n1[0], n1[1], n1[2], n1[3]};
#pragma unroll
              for (int i = 0; i < 8; ++i) { f0[i] = f0[i] * r * qg[0][i]; f1[i] = f1[i] * r * qg[1][i]; const float p = __shfl_xor(f0[i], 16);
                  if (fq == 0) f0[i] = f0[i] * cs[i] - p * sn[i]; else if (fq == 1) f0[i] = f0[i] * cs[i] + p * sn[i]; }
              qf[0] = __builtin_bit_cast(bf16x8, pack8(f0)); qf[1] = __builtin_bit_cast(bf16x8, pack8(f1)); }
            f32x4 st[10];
            float mx = sink;
            const int iq = 16 * qt + fr;
#pragma unroll
            for (int kt = 0; kt < 10; ++kt) { const int ktile = qt + kt, kc = ktile < 15 ? ktile : 15;
                f32x4 acc = (f32x4){0.f, 0.f, 0.f, 0.f};
#pragma unroll
                for (int kk = 0; kk < 2; ++kk) acc = MFMA16(*(const LAS bf16x8*)(KL + (16 * kc + fr) * 72 + kk * 32 + fq * 8), qf[kk], acc);
#pragma unroll
                for (int r = 0; r < 4; ++r) { const int jb = 16 * ktile + 4 * fq + r; const bool ok = (jb > iq) && (jb <= iq + 128) && (blk > 0 || jb >= 128);
                    acc[r] = ok ? acc[r] : -3.0e38f; mx = fmaxf(mx, acc[r]); }
                st[kt] = acc; }
            mx = fmaxf(mx, __shfl_xor(mx, 16)); mx = fmaxf(mx, __shfl_xor(mx, 32));
            float den = 0.f;
#pragma unroll
            for (int kt = 0; kt < 10; ++kt)
#pragma unroll
                for (int r = 0; r < 4; ++r) { const float p = st[kt][r] > -1.0e38f ? __expf(st[kt][r] - mx) : 0.f; st[kt][r] = p; den += p; }
            den += __shfl_xor(den, 16); den += __shfl_xor(den, 32);
            den += __expf(sink - mx);
            const float inv = 1.0f / den;
            f32x4 o[4];
#pragma unroll
            for (int dt = 0; dt < 4; ++dt) o[dt] = (f32x4){0.f, 0.f, 0.f, 0.f};
#pragma unroll
            for (int m = 0; m < 5; ++m) { const int kt0 = qt + 2 * m, kc0 = kt0 < 15 ? kt0 : 15, kc1 = (kt0 + 1) < 15 ? (kt0 + 1) : 15;
                u32x4 pw; pw.x = pk2(st[2 * m][0], st[2 * m][1]); pw.y = pk2(st[2 * m][2], st[2 * m][3]); pw.z = pk2(st[2 * m + 1][0], st[2 * m + 1][1]); pw.w = pk2(st[2 * m + 1][2], st[2 * m + 1][3]);
                const bf16x8 pf = __builtin_bit_cast(bf16x8, pw);
#pragma unroll
                for (int dt = 0; dt < 4; ++dt) { const u32x2 va = *(const LAS u32x2*)(VTL + (16 * dt + fr) * 264 + 16 * kc0 + 4 * fq), vb = *(const LAS u32x2*)(VTL + (16 * dt + fr) * 264 + 16 * kc1 + 4 * fq);
                    const u32x4 vw = (u32x4){va.x, va.y, vb.x, vb.y};
                    o[dt] = MFMA16(__builtin_bit_cast(bf16x8, vw), pf, o[dt]); } }
#pragma unroll
            for (int dt = 0; dt < 4; ++dt) { u32x2 p; p.x = pk2(o[dt][0] * inv, o[dt][1] * inv); p.y = pk2(o[dt][2] * inv, o[dt][3] * inv);
                *(u32x2*)(O + (size_t)tq * D + head * 64 + 16 * dt + 4 * fq) = p; }
        }
    }
}

constexpr int NPH = 19;
#ifndef N_LAUNCHES
#define N_LAUNCHES 1
#endif
__global__ void __launch_bounds__(NTHR, 2) fwd_kernel(Args args) {
    extern __shared__ __attribute__((aligned(16))) unsigned char lds_raw[];
    Ctx X;
    X.lds = (LAS unsigned char*)lds_raw;
    X.tid = threadIdx.x; X.lane = X.tid & 63; X.wave = __builtin_amdgcn_readfirstlane(X.tid >> 6);
    X.G = gridDim.x; { const int bx = blockIdx.x; X.vcu = (X.G % 8 == 0) ? (bx % 8) * (X.G / 8) + bx / 8 : bx; }
    X.gw = X.vcu * NWAVES + X.wave; X.NGW = X.G * NWAVES;
    X.ws = args.ws;
    volatile LAS unsigned* MISC = (volatile LAS unsigned*)(X.lds + MISC_OFF);
    if (X.tid < 64) MISC[X.tid] = 0u;
    __syncthreads();
    unsigned* ctl = (unsigned*)(X.ws + WS_CTL);
    XcdBarrier bar; bar.bar = ctl + CW_BAR; bar.x = 0; bar.st = nullptr;
    if (N_LAUNCHES == 1) bar = xcd_barrier_post(ctl + CW_BAR, MISC + 8);
    const int lo = args.ph_lo, hi = args.ph_hi;
#define IN(k) (lo <= (k) && (k) < hi)
#ifndef REPEAT_MASK
#define REPEAT_MASK 0u
#endif
#define PHASE(k, ...) if (IN(k)) { { __VA_ARGS__ } if ((REPEAT_MASK >> (k)) & 1u) { __VA_ARGS__ } }
#define SEAM(k) do { if (IN(k) && IN((k) + 1)) xcd_barrier(bar); } while (0)
    const Args& a = args;
    bf16* H = (bf16*)(X.ws + WS_H);
    const float* MOD = (const float*)(X.ws + WS_MOD);

    PHASE(0, p0_prologue(X, a);) SEAM(0);
    PHASE(1, p1_norm1(X, a);) SEAM(1);
    PHASE(2, pg8::PlainSched S{H, (const bf16*)(X.ws + WS_WIN_T), 64, 16, X.G, (int)blockIdx.x};
        pg8::EpiBf16 E{(bf16*)(X.ws + WS_PROJ), 4096};
        pg8::gemm_phase(X.lds, S, E);) SEAM(2);
    PHASE(3, p3_prep(X, a);) SEAM(3);
    PHASE(4, p4_scan(X, a);) SEAM(4);
    PHASE(5, p5_onorm(X, a);) SEAM(5);
    PHASE(6, pg8::PlainSched S{(const bf16*)(X.ws + WS_ON), (const bf16*)(X.ws + WS_WOUT_T), 64, 4, X.G, (int)blockIdx.x};
        pg8::EpiResid E{a.in[0], (float*)(X.ws + WS_X1), MOD + 2048};
        pg8::gemm_phase(X.lds, S, E);) SEAM(6);
    PHASE(7, p_norm_router(X, a, 0, (const float*)(X.ws + WS_X1));) SEAM(7);
    PHASE(8, moe_table(X, 0);
        pg8::MoeSched<8, true> S{H, (const bf16*)(X.ws + WS_UP_T), (const int*)(X.ws + WS_LIST), (const LAS int*)(X.lds + TAB_OFF), X.G, X.vcu, (size_t)2048 * 1024};
        pg8::EpiSwiglu E{(bf16*)(X.ws + WS_ACT), a.in[24]};
        pg8::gemm_phase(X.lds, S, E);) SEAM(8);
    PHASE(9, moe_table(X, 0);
        pg8::MoeSched<4, false> S{(const bf16*)(X.ws + WS_ACT), (const bf16*)(X.ws + WS_DOWN_T), (const int*)(X.ws + WS_LIST), (const LAS int*)(X.lds + TAB_OFF), X.G, X.vcu, (size_t)1024 * 1024};
        pg8::EpiDown E{(bf16*)(X.ws + WS_YS), a.in[26], (const int*)(X.ws + WS_LIST)};
        pg8::gemm_phase(X.lds, S, E);) SEAM(9);
    PHASE(10, p10_combine_norm(X, a);) SEAM(10);
    PHASE(11, pg8::KvqSched S{(const bf16*)(X.ws + WS_HKV), (const bf16*)(X.ws + WS_HQ), (const bf16*)(X.ws + WS_KV_T), (const bf16*)(X.ws + WS_WQ_T), X.G, X.vcu};
        pg8::EpiBf16 E{(bf16*)(X.ws + WS_QKV), 1280};
        pg8::gemm_phase(X.lds, S, E);) if (IN(11) && IN(13)) xcd_barrier(bar);
    PHASE(13, p13_attn(X, a);) SEAM(13);
    PHASE(14, pg8::PlainSched S{(const bf16*)(X.ws + WS_O), (const bf16*)(X.ws + WS_BWOUT_T), 64, 4, X.G, (int)blockIdx.x};
        pg8::EpiResid E{(const float*)(X.ws + WS_X2), (float*)(X.ws + WS_X1), MOD + 6144 + 2048};
        pg8::gemm_phase(X.lds, S, E);) SEAM(14);
    PHASE(15, p_norm_router(X, a, 1, (const float*)(X.ws + WS_X1));) SEAM(15);
    PHASE(16, moe_table(X, 1);
        pg8::MoeSched<8, true> S{H, (const bf16*)(X.ws + WS_UP_T) + (size_t)32 * 2048 * 1024, (const int*)(X.ws + WS_LIST), (const LAS int*)(X.lds + TAB_OFF), X.G, X.vcu, (size_t)2048 * 1024};
        pg8::EpiSwiglu E{(bf16*)(X.ws + WS_ACT), a.in[24] + 32 * 2048};
        pg8::gemm_phase(X.lds, S, E);) SEAM(16);
    PHASE(17, moe_table(X, 1);
        pg8::MoeSched<4, false> S{(const bf16*)(X.ws + WS_ACT), (const bf16*)(X.ws + WS_DOWN_T) + (size_t)32 * 1024 * 1024, (const int*)(X.ws + WS_LIST), (const LAS int*)(X.lds + TAB_OFF), X.G, X.vcu, (size_t)1024 * 1024};
        pg8::EpiDown E{(bf16*)(X.ws + WS_YS), a.in[26] + 32 * 1024, (const int*)(X.ws + WS_LIST)};
        pg8::gemm_phase(X.lds, S, E);) SEAM(17);
    PHASE(18, p18_final(X, a);)
#undef IN
#undef SEAM
}

extern "C" void kernel_launch(void* const* d_in, const int* in_sizes, int n_in, void* d_out, int out_size, void* d_ws, size_t ws_size, hipStream_t stream) {
    static int grid = 0;
    if (grid == 0) {
        if (n_in != 27 || out_size != T * D || ws_size < WS_END) { fprintf(stderr, "kernel_launch: unexpected problem (n_in %d, out %d, ws %zu)\n", n_in, out_size, ws_size); grid = -1; return; }
        int dev = 0, cus = 0, per_cu = 0;
        if (hipGetDevice(&dev) != hipSuccess || hipDeviceGetAttribute(&cus, hipDeviceAttributeMultiprocessorCount, dev) != hipSuccess) { grid = -1; return; }
        if (hipFuncSetAttribute((const void*)fwd_kernel, hipFuncAttributeMaxDynamicSharedMemorySize, LDS_BYTES) != hipSuccess) { fprintf(stderr, "kernel_launch: hipFuncSetAttribute failed\n"); grid = -1; return; }
        if (hipOccupancyMaxActiveBlocksPerMultiprocessor(&per_cu, (const void*)fwd_kernel, NTHR, LDS_BYTES) != hipSuccess || per_cu < 1) { fprintf(stderr, "kernel_launch: occupancy query says %d\n", per_cu); (void)hipGetLastError(); }
        grid = cus;
    }
    if (grid < 0) return;
    (void)hipMemsetAsync((char*)d_ws + WS_CTL, 0, CTL_ZERO_BYTES, stream);
    Args a{};
    for (int i = 0; i < 27; ++i) a.in[i] = (const float*)d_in[i];
    a.pos = (const int*)d_in[2]; a.out = (float*)d_out; a.ws = (unsigned char*)d_ws;
    if (N_LAUNCHES == 1) { a.ph_lo = 0; a.ph_hi = NPH; hipLaunchKernelGGL(fwd_kernel, dim3(grid), dim3(NTHR), LDS_BYTES, stream, a); }
    else for (int p = 0; p < NPH; ++p) { a.ph_lo = p; a.ph_hi = p + 1; hipLaunchKernelGGL(fwd_kernel, dim3(grid), dim3(NTHR), LDS_BYTES, stream, a); }
}
```
